# Optimizing an MI355X kernel written in HIP

```python
import jax
import jax.numpy as jnp
import numpy as np

D_MODEL = 1024
BATCH = 2
SEQ = 8192
DEPTH = 4
DEC_BATCH = 16
DEC_SEQ = 2048
PAST_LEN = 128

ATTN_GROUPS = ((128, 1), (512, 4), (2048, 16))
N_GROUPS = len(ATTN_GROUPS)
HEAD_DIM = 64
N_HEADS = D_MODEL // HEAD_DIM
ATTN_WIDTH = N_HEADS * HEAD_DIM
ROPE_THETA = 10000.0
CHUNK = 128
SGU_WIDTH = D_MODEL
SGU_GROUPS = 8
SGU_GC = SGU_WIDTH // SGU_GROUPS
D_FF = 2816
EPS = 1e-6
NEG_INF = -1e30
N_ATTN_LAYERS = (DEPTH + 1) // 2
N_SGU_LAYERS = DEPTH // 2

kernel_name = "hybrid_dilated_attn_sgu_macaron_encoder"


def rms_norm(x, g):
    xf = x.astype(jnp.float32)
    y = xf * jax.lax.rsqrt(jnp.mean(xf * xf, axis=-1, keepdims=True) + EPS)
    return (y * g.astype(jnp.float32)).astype(x.dtype)


def layer_norm(x, g, b):
    xf = x.astype(jnp.float32)
    mu = jnp.mean(xf, axis=-1, keepdims=True)
    var = jnp.mean(jnp.square(xf - mu), axis=-1, keepdims=True)
    y = (xf - mu) * jax.lax.rsqrt(var + EPS)
    return (y * g.astype(jnp.float32) + b.astype(jnp.float32)).astype(x.dtype)


def rope(t):
    S, E = t.shape[1], t.shape[-1]
    half = E // 2
    inv = ROPE_THETA ** (-jnp.arange(half, dtype=jnp.float32) / half)
    ang = jnp.arange(S, dtype=jnp.float32)[:, None] * inv[None, :]
    shape = (S,) + (1,) * (t.ndim - 3) + (half,)
    cos = jnp.cos(ang).reshape(shape).astype(t.dtype)
    sin = jnp.sin(ang).reshape(shape).astype(t.dtype)
    t1, t2 = t[..., :half], t[..., half:]
    return jnp.concatenate([t1 * cos - t2 * sin, t2 * cos + t1 * sin], axis=-1)


def swiglu(h, w_in, w_out):
    gate, up = jnp.split(h @ w_in, 2, axis=-1)
    return (jax.nn.silu(gate) * up) @ w_out


def dilated_window_attention(q, k, v, window, dilation):
    B, S, H, E = q.shape
    radius = window // (2 * dilation)
    blk = radius
    L = S // dilation
    nb = -(-L // blk)
    Lp = nb * blk

    def split(t):
        t = t.reshape(B, L, dilation, H, E).transpose(0, 2, 1, 3, 4)
        return jnp.pad(t, ((0, 0), (0, 0), (0, Lp - L), (0, 0), (0, 0)))

    def band(t):
        t = jnp.pad(split(t), ((0, 0), (0, 0), (blk, blk), (0, 0), (0, 0)))
        t = t.reshape(B, dilation, nb + 2, blk, H, E)
        return jnp.concatenate([t[:, :, :-2], t[:, :, 1:-1], t[:, :, 2:]], axis=3)

    qs = split(q).reshape(B, dilation, nb, blk, H, E)
    kb, vb = band(k), band(v)
    s = jnp.einsum('brnqhe,brnkhe->brnhqk', qs, kb,
                   preferred_element_type=jnp.float32) * (E ** -0.5)
    qpos = np.arange(nb)[:, None] * blk + np.arange(blk)[None, :]
    kpos = np.arange(nb)[:, None] * blk - blk + np.arange(3 * blk)[None, :]
    off = kpos[:, None, :] - qpos[:, :, None]
    valid = (np.abs(off) <= radius) & (kpos[:, None, :] >= 0) & (kpos[:, None, :] < L)
    s = jnp.where(jnp.asarray(valid)[None, None, :, None], s, NEG_INF)
    m = jnp.max(s, axis=-1, keepdims=True)
    p = jnp.exp(s - m)
    denom = jnp.sum(p, axis=-1, keepdims=True)
    o = jnp.einsum('brnhqk,brnkhe->brnqhe', (p / denom).astype(v.dtype), vb)
    lse = (m + jnp.log(denom))[..., 0]
    o = o.reshape(B, dilation, Lp, H, E)[:, :, :L].transpose(0, 2, 1, 3, 4).reshape(B, S, H, E)
    lse = lse.transpose(0, 1, 2, 4, 3).reshape(B, dilation, Lp, H)[:, :, :L]
    lse = lse.transpose(0, 2, 1, 3).reshape(B, S, H)
    return o, lse


def attention_mixer(h, w_qkv, q_norm, k_norm, w_o):
    B, S, _ = h.shape
    qkv = (h @ w_qkv).reshape(B, S, 3, N_GROUPS, N_HEADS, HEAD_DIM)
    q = rope(rms_norm(qkv[:, :, 0], q_norm))
    k = rope(rms_norm(qkv[:, :, 1], k_norm))
    v = qkv[:, :, 2]
    outs, lses = [], []
    for g, (window, dilation) in enumerate(ATTN_GROUPS):
        o_g, lse_g = dilated_window_attention(q[:, :, g], k[:, :, g], v[:, :, g], window, dilation)
        outs.append(o_g)
        lses.append(lse_g)
    wts = jax.nn.softmax(jnp.stack(lses, axis=0), axis=0).astype(v.dtype)
    o = jnp.einsum('gbsh,gbshe->bshe', wts, jnp.stack(outs, axis=0))
    return o.reshape(B, S, ATTN_WIDTH) @ w_o


def sgu_mixer(h, w_in, b_in, ln_g, ln_b, w_s, b_s, w_out):
    B, S, _ = h.shape
    z = jax.nn.gelu(h @ w_in + b_in)
    u, v = jnp.split(z, 2, axis=-1)
    v = layer_norm(v, ln_g, ln_b).reshape(B, S // CHUNK, CHUNK, SGU_GROUPS, SGU_GC)
    v = jnp.einsum('gpq,bnqgc->bnpgc', w_s, v) + b_s.T[:, :, None]
    return (u * v.reshape(B, S, SGU_WIDTH)) @ w_out


def trunk(x, ffn1_norm, ffn1_w_in, ffn1_w_out, mix_norm, attn_w_qkv, attn_q_norm, attn_k_norm,
          attn_w_o, sgu_w_in, sgu_b_in, sgu_ln_g, sgu_ln_b, sgu_w_s, sgu_b_s, sgu_w_out,
          ffn2_norm, ffn2_w_in, ffn2_w_out, out_norm):
    for i in range(DEPTH):
        x = x + 0.5 * swiglu(rms_norm(x, ffn1_norm[i]), ffn1_w_in[i], ffn1_w_out[i])
        h = rms_norm(x, mix_norm[i])
        j = i // 2
        if i % 2 == 0:
            x = x + attention_mixer(h, attn_w_qkv[j], attn_q_norm[j], attn_k_norm[j], attn_w_o[j])
        else:
            x = x + sgu_mixer(h, sgu_w_in[j], sgu_b_in[j], sgu_ln_g[j], sgu_ln_b[j],
                              sgu_w_s[j], sgu_b_s[j], sgu_w_out[j])
        x = x + 0.5 * swiglu(rms_norm(x, ffn2_norm[i]), ffn2_w_in[i], ffn2_w_out[i])
        x = rms_norm(x, out_norm[i])
    return x


def setup_inputs(seed: int = 0) -> dict:
    key = jax.random.key(seed)
    ks = jax.random.split(key, 24)

    def nrm(k, shape, scale):
        return jax.random.normal(k, shape, jnp.float32) * scale

    def gain(k, shape):
        return 1.0 + 0.05 * jax.random.normal(k, shape, jnp.float32)

    D = D_MODEL
    qkv_w = 3 * N_GROUPS * ATTN_WIDTH
    return {
        "x_prompt": nrm(ks[0], (BATCH, SEQ, D), 1.0),
        "x_sample": nrm(ks[1], (DEC_BATCH, DEC_SEQ, D), 1.0),
        "ffn1_norm": gain(ks[2], (DEPTH, D)),
        "ffn1_w_in": nrm(ks[3], (DEPTH, D, 2 * D_FF), D ** -0.5),
        "ffn1_w_out": nrm(ks[4], (DEPTH, D_FF, D), D_FF ** -0.5),
        "mix_norm": gain(ks[5], (DEPTH, D)),
        "attn_w_qkv": nrm(ks[6], (N_ATTN_LAYERS, D, qkv_w), D ** -0.5),
        "attn_q_norm": gain(ks[7], (N_ATTN_LAYERS, HEAD_DIM)),
        "attn_k_norm": gain(ks[8], (N_ATTN_LAYERS, HEAD_DIM)),
        "attn_w_o": nrm(ks[9], (N_ATTN_LAYERS, ATTN_WIDTH, D), ATTN_WIDTH ** -0.5),
        "sgu_w_in": nrm(ks[10], (N_SGU_LAYERS, D, 2 * SGU_WIDTH), D ** -0.5),
        "sgu_b_in": nrm(ks[11], (N_SGU_LAYERS, 2 * SGU_WIDTH), 0.02),
        "sgu_ln_g": gain(ks[12], (N_SGU_LAYERS, SGU_WIDTH)),
        "sgu_ln_b": nrm(ks[13], (N_SGU_LAYERS, SGU_WIDTH), 0.02),
        "sgu_w_s": nrm(ks[14], (N_SGU_LAYERS, SGU_GROUPS, CHUNK, CHUNK), CHUNK ** -0.5),
        "sgu_b_s": 1.0 + nrm(ks[15], (N_SGU_LAYERS, SGU_GROUPS, CHUNK), 0.01),
        "sgu_w_out": nrm(ks[16], (N_SGU_LAYERS, SGU_WIDTH, D), SGU_WIDTH ** -0.5),
        "ffn2_norm": gain(ks[17], (DEPTH, D)),
        "ffn2_w_in": nrm(ks[18], (DEPTH, D, 2 * D_FF), D ** -0.5),
        "ffn2_w_out": nrm(ks[19], (DEPTH, D_FF, D), D_FF ** -0.5),
        "out_norm": gain(ks[20], (DEPTH, D)),
    }


def reference(x_prompt, x_sample, ffn1_norm, ffn1_w_in, ffn1_w_out, mix_norm, attn_w_qkv,
              attn_q_norm, attn_k_norm, attn_w_o, sgu_w_in, sgu_b_in, sgu_ln_g, sgu_ln_b,
              sgu_w_s, sgu_b_s, sgu_w_out, ffn2_norm, ffn2_w_in, ffn2_w_out, out_norm):
    y_prompt = trunk(x_prompt, ffn1_norm, ffn1_w_in, ffn1_w_out, mix_norm, attn_w_qkv,
                     attn_q_norm, attn_k_norm, attn_w_o, sgu_w_in, sgu_b_in, sgu_ln_g, sgu_ln_b,
                     sgu_w_s, sgu_b_s, sgu_w_out, ffn2_norm, ffn2_w_in, ffn2_w_out, out_norm)
    y_sample = trunk(x_sample, ffn1_norm, ffn1_w_in, ffn1_w_out, mix_norm, attn_w_qkv,
                     attn_q_norm, attn_k_norm, attn_w_o, sgu_w_in, sgu_b_in, sgu_ln_g, sgu_ln_b,
                     sgu_w_s, sgu_b_s, sgu_w_out, ffn2_norm, ffn2_w_in, ffn2_w_out, out_norm)
    return (y_prompt, y_sample)
```

```cpp
#include <hip/hip_runtime.h>
#include <hip/hip_cooperative_groups.h>
#include <cstdio>
#include <cstdint>
namespace cg = cooperative_groups;
namespace pg8 {
#define PG8_LAS __attribute__((address_space(3)))
typedef unsigned short bf16_t;
typedef short bf16x8 __attribute__((ext_vector_type(8)));
typedef float f32x4 __attribute__((ext_vector_type(4)));
typedef unsigned u32x4 __attribute__((ext_vector_type(4)));
constexpr int BM = 256, BK = 64, HALF = 128, HTB = HALF * BK * 2  , STAGE_BYTES = 8 * HTB, NXCD = 8, WGM = 8;

__host__ __device__ __forceinline__ int lds_byte(int r, int c) { const int st = (r >> 4) * 2 + (c >> 5), rr = r & 15, cc = c & 31, ob = rr * 64 + cc * 2; return st * 1024 + (ob ^ (((ob >> 9) & 1) << 5)); }
__host__ __device__ __forceinline__ void stage_rc(int b, int& R, int& C) { const int st = b / 1024, sb = b % 1024, swz = sb ^ (((sb >> 9) & 1) << 5); R = (st >> 1) * 16 + swz / 64; C = (st & 1) * 32 + (swz % 64) / 2; }
__host__ __device__ __forceinline__ int perm32(int rho) { const int n = rho >> 4, i = rho & 15; return 8 * (i >> 2) + 4 * n + (i & 3); }

struct Unit { int pm, pn, idx; };
struct Gemm { const bf16_t* A; const bf16_t* Bt; int M, N, K; };

struct StaticOrder {
    int nM, nN, nwg, G, c, rev, wgm;
    __host__ __device__ void init(int M, int N, int G_, int c_, int rev_ = 0, int wgm_ = WGM) { nM = M / BM; nN = N / BM; nwg = nM * nN; G = G_; c = c_; rev = rev_; wgm = wgm_; }
    __host__ __device__ bool next(int i, Unit& u) const {
        const long L = (long)i * G + c; if (L >= nwg) return false;
        int wgid = (int)L; { const int q = nwg / NXCD, r = nwg % NXCD, xcd = wgid % NXCD, off = wgid / NXCD; wgid = (xcd < r ? xcd * (q + 1) : r * (q + 1) + (xcd - r) * q) + off; }
        const int nig = wgm * nN, gid = wgid / nig, fm = gid * wgm, gsz = (nM - fm) < wgm ? (nM - fm) : wgm;
        u.pm = fm + ((wgid % nig) % gsz); u.pn = (wgid % nig) / gsz; u.idx = i; if (rev) u.pm = nM - 1 - u.pm; return true;
    }
    __device__ __forceinline__ void a_ready(const Unit&) const {}
    __device__ __forceinline__ void done(const Unit&) const {}
};

__device__ __forceinline__ unsigned cvt_pk_bf16(float lo, float hi) { unsigned r; asm volatile("v_cvt_pk_bf16_f32 %0, %1, %2" : "=v"(r) : "v"(lo), "v"(hi)); return r; }
typedef float f32x2 __attribute__((ext_vector_type(2)));
template <class Epi, class Sched, bool ALIGN_EPI = false, bool SP2 = false>
__device__ __forceinline__ void gemm_phase(PG8_LAS unsigned char* lds, const Gemm g, const Sched& S, const Epi& E, int tid_in) {
    int tid = tid_in; asm volatile("" : "+v"(tid)); const int wid = __builtin_amdgcn_readfirstlane(tid >> 6), lane = tid & 63, wr = wid >> 2, wc = wid & 3, fr = lane & 15, fq = lane >> 4;
    const int K = g.K, nt = K / BK;
    unsigned voffA[2], voffB[2];
#pragma unroll
    for (int i = 0; i < 2; ++i) { int R, C; stage_rc(tid * 16 + i * 8192, R, C); const int Rb = Epi::PERM ? ((R & ~31) + perm32(R & 31)) : R;
        voffA[i] = (unsigned)(R * K + C) * 2u; voffB[i] = (unsigned)(Rb * K + C) * 2u; }
    const size_t kstep = (size_t)(BK * 2);
    const size_t hstep = (size_t)HALF * K * 2;
    const size_t tstep = 2 * hstep;
    const unsigned ldsw = (unsigned)wid * 1024u;
    const int aoff = lds_byte(wr * 64 + fr, fq * 8), boff = lds_byte(wc * 32 + fr, fq * 8);
#define PG8_SA(b, h) (((b) * 2 + (h)) * HTB)
#define PG8_SB(b, h) ((4 + (b) * 2 + (h)) * HTB)
#define PG8_STAGE(bufoff, gbase, voff) do { _Pragma("unroll") for (int _i = 0; _i < 2; ++_i) \
        __builtin_amdgcn_global_load_lds((const unsigned*)((const char*)(gbase) + (voff)[_i]), (PG8_LAS unsigned*)(lds + (bufoff) + ldsw + _i * 8192), 16, 0, 0); } while (0)
#define PG8_LDA(dst, b, h) do { _Pragma("unroll") for (int m = 0; m < 4; ++m) _Pragma("unroll") for (int k = 0; k < 2; ++k) dst[m][k] = *(const PG8_LAS bf16x8*)(lds + PG8_SA(b, h) + aoff + m * 2048 + k * 1024); } while (0)
#define PG8_LDB(dst, b, h) do { _Pragma("unroll") for (int n = 0; n < 2; ++n) _Pragma("unroll") for (int k = 0; k < 2; ++k) dst[n][k] = *(const PG8_LAS bf16x8*)(lds + PG8_SB(b, h) + boff + n * 2048 + k * 1024); } while (0)
#define PG8_MMA(ai, bj, At, Bt) do { __builtin_amdgcn_s_setprio(1); _Pragma("unroll") for (int m = 0; m < 4; ++m) _Pragma("unroll") for (int n = 0; n < 2; ++n) _Pragma("unroll") for (int k = 0; k < 2; ++k) \
        acc[ai][bj][m][n] = __builtin_amdgcn_mfma_f32_16x16x32_bf16(Bt[n][k], At[m][k], acc[ai][bj][m][n], 0, 0, 0); __builtin_amdgcn_s_setprio(0); } while (0)
#define PG8_WAIT_V(n) asm volatile("s_waitcnt vmcnt(" #n ")" ::: "memory")
#define PG8_WAIT_L(n) asm volatile("s_waitcnt lgkmcnt(" #n ")" ::: "memory")
#define PG8_BAR __builtin_amdgcn_s_barrier()
#define PG8_SCHED __builtin_amdgcn_sched_barrier(0)
    Unit cur, nxt; int ui = 0;
    if (!S.next(0, cur)) return;
    f32x4 acc[2][2][4][2];
#pragma unroll
    for (int a = 0; a < 2; ++a)
#pragma unroll
        for (int b = 0; b < 2; ++b)
#pragma unroll
            for (int m = 0; m < 4; ++m)
#pragma unroll
                for (int n = 0; n < 2; ++n) acc[a][b][m][n] = (f32x4){0.f, 0.f, 0.f, 0.f};
    bf16x8 At[4][2], B0[2][2], B1[2][2];
    const char* cA = (const char*)g.A + (size_t)cur.pm * tstep; const char* cB = (const char*)g.Bt + (size_t)cur.pn * tstep;
    S.a_ready(cur);
    if constexpr (SP2) {
        PG8_STAGE(PG8_SB(0, 0), cB, voffB); PG8_STAGE(PG8_SB(0, 1), cB + hstep, voffB); PG8_STAGE(PG8_SA(0, 0), cA, voffA); PG8_STAGE(PG8_SA(0, 1), cA + hstep, voffA);
        if (wr == 1) PG8_BAR;
        PG8_WAIT_V(2); PG8_BAR;
        PG8_STAGE(PG8_SB(1, 0), cB + kstep, voffB); PG8_STAGE(PG8_SA(1, 0), cA + kstep, voffA); PG8_STAGE(PG8_SB(1, 1), cB + hstep + kstep, voffB);
        PG8_WAIT_V(6); PG8_BAR;
    } else {
        PG8_STAGE(PG8_SB(0, 0), cB, voffB); PG8_STAGE(PG8_SA(0, 0), cA, voffA); PG8_STAGE(PG8_SB(0, 1), cB + hstep, voffB); PG8_STAGE(PG8_SA(0, 1), cA + hstep, voffA);
        if (wr == 1) PG8_BAR;
        PG8_WAIT_V(4); PG8_BAR;
        PG8_STAGE(PG8_SB(1, 0), cB + kstep, voffB); PG8_STAGE(PG8_SA(1, 0), cA + kstep, voffA); PG8_STAGE(PG8_SB(1, 1), cB + hstep + kstep, voffB);
        PG8_WAIT_V(6); PG8_BAR;
    }
    for (;;) {
        const bool has_next = S.next(ui + 1, nxt);
        const char* nA = has_next ? (const char*)g.A + (size_t)nxt.pm * tstep : cA; const char* nB = has_next ? (const char*)g.Bt + (size_t)nxt.pn * tstep : cB;
        for (int t = 0; t < nt; t += 2) {
            const bool last = (t == nt - 2);
            const char* a1 = cA + (size_t)(t + 1) * kstep;
            const char* a2 = last ? nA : cA + (size_t)(t + 2) * kstep; const char* b2 = last ? nB : cB + (size_t)(t + 2) * kstep;
            const char* a3 = a2 + kstep; const char* b3 = b2 + kstep;
            if (last && has_next) S.a_ready(nxt);
            if constexpr (SP2) {
            PG8_LDB(B0, 0, 0); PG8_LDB(B1, 0, 1); PG8_SCHED; PG8_LDA(At, 0, 0); PG8_STAGE(PG8_SA(1, 1), a1 + hstep, voffA);
            PG8_WAIT_V(8); PG8_WAIT_L(0); PG8_BAR; PG8_MMA(0, 0, At, B0); PG8_MMA(0, 1, At, B1); PG8_BAR; PG8_SCHED;
            PG8_LDA(At, 0, 1); PG8_STAGE(PG8_SB(0, 0), b2, voffB); PG8_STAGE(PG8_SB(0, 1), b2 + hstep, voffB); PG8_STAGE(PG8_SA(0, 0), a2, voffA);
            PG8_WAIT_V(8); PG8_WAIT_L(0); PG8_BAR; PG8_MMA(1, 0, At, B0); PG8_MMA(1, 1, At, B1); PG8_BAR; PG8_SCHED;
            PG8_LDB(B0, 1, 0); PG8_LDB(B1, 1, 1); PG8_SCHED; PG8_LDA(At, 1, 0); PG8_STAGE(PG8_SA(0, 1), a2 + hstep, voffA);
            PG8_WAIT_V(8); PG8_WAIT_L(0); PG8_BAR; PG8_MMA(0, 0, At, B0); PG8_MMA(0, 1, At, B1); PG8_BAR; PG8_SCHED;
            PG8_LDA(At, 1, 1); PG8_STAGE(PG8_SB(1, 0), b3, voffB); PG8_STAGE(PG8_SB(1, 1), b3 + hstep, voffB); PG8_STAGE(PG8_SA(1, 0), a3, voffA);
            PG8_WAIT_V(8); PG8_WAIT_L(0); PG8_BAR; PG8_MMA(1, 0, At, B0); PG8_MMA(1, 1, At, B1); PG8_BAR; PG8_SCHED;
            } else {
            PG8_LDB(B0, 0, 0); PG8_SCHED; PG8_LDA(At, 0, 0); PG8_STAGE(PG8_SA(1, 1), a1 + hstep, voffA);
            PG8_WAIT_L(8); PG8_BAR; PG8_WAIT_L(0); PG8_MMA(0, 0, At, B0); PG8_BAR; PG8_SCHED;
            PG8_LDB(B1, 0, 1); PG8_STAGE(PG8_SB(0, 0), b2, voffB);
            PG8_BAR; PG8_WAIT_L(0); PG8_MMA(0, 1, At, B1); PG8_BAR;
            PG8_LDA(At, 0, 1); PG8_STAGE(PG8_SA(0, 0), a2, voffA);
            PG8_BAR; PG8_WAIT_L(0); PG8_MMA(1, 0, At, B0); PG8_BAR; PG8_SCHED;
            PG8_STAGE(PG8_SB(0, 1), b2 + hstep, voffB);
            PG8_WAIT_V(6); PG8_BAR; PG8_MMA(1, 1, At, B1); PG8_BAR;
            PG8_LDB(B0, 1, 0); PG8_SCHED; PG8_LDA(At, 1, 0); PG8_STAGE(PG8_SA(0, 1), a2 + hstep, voffA);
            PG8_WAIT_L(8); PG8_BAR; PG8_WAIT_L(0); PG8_MMA(0, 0, At, B0); PG8_BAR; PG8_SCHED;
            PG8_LDB(B1, 1, 1); PG8_STAGE(PG8_SB(1, 0), b3, voffB);
            PG8_BAR; PG8_WAIT_L(0); PG8_MMA(0, 1, At, B1); PG8_BAR;
            PG8_LDA(At, 1, 1); PG8_STAGE(PG8_SA(1, 0), a3, voffA);
            PG8_BAR; PG8_WAIT_L(0); PG8_MMA(1, 0, At, B0); PG8_BAR; PG8_SCHED;
            PG8_STAGE(PG8_SB(1, 1), b3 + hstep, voffB);
            PG8_WAIT_V(6); PG8_BAR; PG8_MMA(1, 1, At, B1); PG8_BAR;
            }
        }
        if constexpr (ALIGN_EPI) { if (wr == 0) PG8_BAR; }
        if constexpr (!Epi::AFTER_DRAIN) { E(acc, cur, wr, wc, fr, fq); S.done(cur); }
        if (!has_next) break;
#pragma unroll
        for (int a = 0; a < 2; ++a)
#pragma unroll
            for (int b = 0; b < 2; ++b)
#pragma unroll
                for (int m = 0; m < 4; ++m)
#pragma unroll
                    for (int n = 0; n < 2; ++n) acc[a][b][m][n] = (f32x4){0.f, 0.f, 0.f, 0.f};
        cur = nxt; cA = nA; cB = nB; ++ui;
        if constexpr (ALIGN_EPI) { if (wr == 1) PG8_BAR; }
    }
    PG8_WAIT_V(0);
    if constexpr (!ALIGN_EPI) { if (wr == 0) PG8_BAR; }
    PG8_BAR;
    if constexpr (Epi::AFTER_DRAIN) { E.fused(acc, cur, wr, wc, fr, fq, lds, wid, lane); S.done(cur); }
#undef PG8_SA
#undef PG8_SB
#undef PG8_STAGE
#undef PG8_LDA
#undef PG8_LDB
#undef PG8_MMA
#undef PG8_WAIT_V
#undef PG8_WAIT_L
#undef PG8_BAR
#undef PG8_SCHED
}
}
#define LAS __attribute__((address_space(3)))
#define XB_TMO      128
#define XB_XCNT(j)  (256  + 64 * (j))
#define XB_XSUB(j)  (1280 + 64 * (j))
#define XB_XGEN(j)  (2304 + 64 * (j))
#define XB_TOP      3328
#define XB_TOPGEN   3392
#define XCD_BAR_WORDS 3456
#define XB_SPIN_CAP (1u << 18)

__device__ __forceinline__ unsigned xb_ld(unsigned* p)              { return __hip_atomic_load(p, __ATOMIC_RELAXED, __HIP_MEMORY_SCOPE_AGENT); }
__device__ __forceinline__ unsigned xb_add(unsigned* p, unsigned v) { return __hip_atomic_fetch_add(p, v, __ATOMIC_RELAXED, __HIP_MEMORY_SCOPE_AGENT); }
__device__ __forceinline__ unsigned xb_xcc_id() { return (unsigned)__builtin_amdgcn_s_getreg((3 << 11) | 20) & 0xFu; }
#define XB_SPIN(cond, bar) do { unsigned _sp = 0; while (cond) { __builtin_amdgcn_s_sleep(1); \
    if ((++_sp & 255u) == 0u) { if (xb_ld(&(bar)[XB_TMO])) break; if (_sp > XB_SPIN_CAP) { atomicAdd(&(bar)[XB_TMO], 1u); break; } } } } while (0)

struct XcdBarrier {
    unsigned* bar; unsigned x;
    volatile LAS unsigned* st;
};

__device__ __forceinline__ XcdBarrier xcd_barrier_post(unsigned* bar, volatile LAS unsigned* st) {
    XcdBarrier b; b.bar = bar; b.x = xb_xcc_id(); b.st = st;
    if (threadIdx.x == 0) (void)xb_add(&bar[XB_XCNT(b.x)], 1u);
    return b;
}
__device__ __forceinline__ void xcd_barrier_complete(unsigned* bar, unsigned x, unsigned& nloc, unsigned& nx) {
    const unsigned G = gridDim.x * gridDim.y * gridDim.z;
    unsigned sum, cnt, mine, sp = 0u;
    for (;;) {
        sum = 0u; cnt = 0u; mine = 0u;
#pragma unroll
        for (unsigned j = 0; j < 16; ++j) { const unsigned c = xb_ld(&bar[XB_XCNT(j)]); sum += c; cnt += (c > 0u) ? 1u : 0u; mine = (j == x) ? c : mine; }
        if (sum == G) break;
        __builtin_amdgcn_s_sleep(1);
        if ((++sp & 255u) == 0u) { if (xb_ld(&bar[XB_TMO])) break; if (sp > XB_SPIN_CAP) { atomicAdd(&bar[XB_TMO], 1u); break; } }
    }
    nloc = mine > 0u ? mine : 1u; nx = cnt > 0u ? cnt : 1u;
}

__device__ __forceinline__ void xcd_barrier(const XcdBarrier& b, int tid_in) {
    asm volatile("s_waitcnt vmcnt(0)" ::: "memory");
    __syncthreads();
    if (tid_in == 0) {
        unsigned* bar = b.bar;
        __builtin_amdgcn_s_waitcnt(0);
        unsigned nloc = b.st[0], nx = b.st[1];
        if (nloc == 0u) { xcd_barrier_complete(bar, b.x, nloc, nx); b.st[0] = nloc; b.st[1] = nx; }
        const unsigned old = xb_add(&bar[XB_XSUB(b.x)], 1u);
        const unsigned gen = old / nloc;
        if (old + 1u == (gen + 1u) * nloc) {
            __builtin_amdgcn_fence(__ATOMIC_RELEASE, "agent");
            asm volatile("s_waitcnt vmcnt(0)" ::: "memory");
            const unsigned og = xb_add(&bar[XB_TOP], 1u);
            const unsigned tg = og / nx;
            if (og + 1u == (tg + 1u) * nx) xb_add(&bar[XB_TOPGEN], 1u);
            else XB_SPIN(xb_ld(&bar[XB_TOPGEN]) == tg, bar);
            __builtin_amdgcn_fence(__ATOMIC_ACQUIRE, "agent");
            xb_add(&bar[XB_XGEN(b.x)], 1u);
            asm volatile("s_waitcnt vmcnt(0)" ::: "memory");
        } else {
            XB_SPIN(xb_ld(&bar[XB_XGEN(b.x)]) == gen, bar);
            __builtin_amdgcn_fence(__ATOMIC_ACQUIRE, "agent");
            asm volatile("s_waitcnt vmcnt(0)" ::: "memory");
        }
    }
    __syncthreads();
}


using pg8::bf16_t; using pg8::bf16x8; using pg8::f32x4; using pg8::u32x4;
typedef float f32x16 __attribute__((ext_vector_type(16)));
typedef short s16x4 __attribute__((ext_vector_type(4)));
typedef unsigned u32x2 __attribute__((ext_vector_type(2)));
typedef float f32x2_t __attribute__((ext_vector_type(2))); typedef __bf16 bf16x2_t __attribute__((ext_vector_type(2)));
#define LAS __attribute__((address_space(3)))
#define MFMA32(a, b, c) __builtin_amdgcn_mfma_f32_32x32x16_bf16((a), (b), (c), 0, 0, 0)

constexpr int D = 1024, T = 49152, TP = 16384, FF = 2816, DEPTH = 4, QKVW = 9216;
constexpr int CH = 8192, NCH = T / CH;
constexpr float EPS = 1e-6f, LOG2E = 1.4426950408889634f;
constexpr int NWAVES = 8, NTHR = 512;

constexpr size_t MiB = 1u << 20;
constexpr size_t WS_ROPE = 1 * MiB;
constexpr size_t WS_STATS = 3 * MiB;
constexpr size_t WS_LSE = 4 * MiB;
constexpr size_t WS_W = 6 * MiB;
constexpr size_t E_FIN = (size_t)2 * FF * D, E_FOUT = (size_t)FF * D;
constexpr size_t E_LAYER = 2 * (E_FIN + E_FOUT);
constexpr size_t E_QKV = (size_t)QKVW * D, E_WO = (size_t)D * D, E_ATT = E_QKV + E_WO;
constexpr size_t E_SIN = (size_t)2 * D * D, E_SOUT = (size_t)D * D, E_WS = 8 * 128 * 128, E_SGU = E_SIN + E_SOUT + E_WS;
constexpr size_t E_WTOT = DEPTH * E_LAYER + 2 * E_ATT + 2 * E_SGU;
constexpr size_t WS_H = WS_W + ((E_WTOT * 2 + MiB - 1) / MiB) * MiB;
constexpr size_t WS_BIG = WS_H + (size_t)T * D * 2;
constexpr size_t WS_PA = WS_BIG + (size_t)T * FF * 2;
constexpr size_t WS_PB = WS_PA + (size_t)T * 16 * 4;
constexpr size_t WS_PC = WS_PB + (size_t)T * 16 * 4;
constexpr size_t WS_END = WS_PC + (size_t)T * 16 * 4;
constexpr size_t WS_W1 = 3 * MiB + 256 * 1024;
constexpr size_t WS_R2 = 3 * MiB;
static_assert(WS_END <= (size_t)588358656, "d_ws is only guaranteed to hold the inputs' bytes");
constexpr size_t BIG_OG = (size_t)CH * QKVW * 2;
constexpr size_t BIG_V = (size_t)T * D * 2;
constexpr size_t BIG_ST = 2 * BIG_V;
static_assert(BIG_OG + (size_t)3 * CH * D * 2 <= (size_t)T * FF * 2 && BIG_ST + (size_t)T * 32 * 4 <= (size_t)T * FF * 2, "BIG overlays");

struct Params {
    const float* in[21];
    float* out; unsigned char* ws;
    int ph_lo, ph_hi;
};

__device__ __forceinline__ unsigned cvtpk(float lo, float hi) { f32x2_t v = {lo, hi}; bf16x2_t b = __builtin_convertvector(v, bf16x2_t); return __builtin_bit_cast(unsigned, b); }
__device__ __forceinline__ float bflo(unsigned u) { return __builtin_bit_cast(float, u << 16); }
__device__ __forceinline__ float bfhi(unsigned u) { return __builtin_bit_cast(float, u & 0xffff0000u); }
__device__ __forceinline__ float wave_sum(float v) {
#pragma unroll
    for (int o = 32; o >= 1; o >>= 1) v += __shfl_xor(v, o);
    return v;
}

struct EpiSwiglu {
    static constexpr bool PERM = true, AFTER_DRAIN = false;
    bf16_t* Hd; const LAS float* scr;
    __device__ __forceinline__ void operator()(const f32x4 (&acc)[2][2][4][2], const pg8::Unit& u, int wr, int wc, int fr, int fq) const {
        const int row0 = u.pm * 256 + wr * 64 + fr, col0 = u.pn * 128 + wc * 32 + 8 * fq;
#pragma unroll
        for (int ai = 0; ai < 2; ++ai)
#pragma unroll
            for (int m = 0; m < 4; ++m) {
                bf16_t* p = Hd + (size_t)(row0 + ai * 128 + m * 16) * FF + col0;
                const float rsc = scr[u.idx * 256 + wr * 64 + fr + ai * 128 + m * 16];
                const float nrl = -rsc * LOG2E, ir2 = __builtin_amdgcn_rcpf(rsc * rsc);
                float h[8];
#pragma unroll
                for (int n = 0; n < 2; ++n)
#pragma unroll
                    for (int j = 0; j < 4; ++j) { const float ag = acc[ai][0][m][n][j], au = acc[ai][1][m][n][j];
                        const float e = __builtin_amdgcn_exp2f(ag * nrl);
                        h[n * 4 + j] = (ag * au) * __builtin_amdgcn_rcpf(__builtin_fmaf(e, ir2, ir2)); }
                u32x4 w; w.x = pg8::cvt_pk_bf16(h[0], h[1]); w.y = pg8::cvt_pk_bf16(h[2], h[3]); w.z = pg8::cvt_pk_bf16(h[4], h[5]); w.w = pg8::cvt_pk_bf16(h[6], h[7]);
                *(u32x4*)p = w;
            }
    }
};
struct EpiResid {
    static constexpr bool PERM = true, AFTER_DRAIN = false;
    bf16_t* X; float scale; float* part; const LAS float* tabin; const float* gin; float* part2; const float* gout;
    __device__ __forceinline__ void operator()(const f32x4 (&acc)[2][2][4][2], const pg8::Unit& u, int wr, int wc, int fr, int fq) const {
        const int row0 = u.pm * 256 + wr * 64 + fr, col0 = u.pn * 256 + wc * 32 + 8 * fq;
        const float* gsel = gin ? gin : gout;
        f32x4 gv[2][2];
#pragma unroll
        for (int bj = 0; bj < 2; ++bj)
#pragma unroll
            for (int n = 0; n < 2; ++n) gv[bj][n] = gsel ? *(const f32x4*)(gsel + col0 + bj * 128 + 4 * n) : (f32x4){1.f, 1.f, 1.f, 1.f};
#pragma unroll
        for (int am = 0; am < 4; ++am) {
            const int ai = am >> 1, mb = (am & 1) * 2;
            u32x4 xr[2][2]; float rin[2];
#pragma unroll
            for (int mm = 0; mm < 2; ++mm) {
                rin[mm] = gin ? tabin[u.idx * 256 + wr * 64 + fr + ai * 128 + (mb + mm) * 16] : 1.0f;
#pragma unroll
                for (int bj = 0; bj < 2; ++bj) xr[mm][bj] = *(const u32x4*)(X + (size_t)(row0 + ai * 128 + (mb + mm) * 16) * D + col0 + bj * 128);
            }
#pragma unroll
            for (int mm = 0; mm < 2; ++mm) {
                float ss = 0.f, ss2 = 0.f;
#pragma unroll
                for (int bj = 0; bj < 2; ++bj) {
                    const f32x4 a0 = acc[ai][bj][mb + mm][0], a1 = acc[ai][bj][mb + mm][1]; const u32x4 x = xr[mm][bj]; u32x4 w;
                    f32x4 x0 = {bflo(x.x), bfhi(x.x), bflo(x.y), bfhi(x.y)}, x1 = {bflo(x.z), bfhi(x.z), bflo(x.w), bfhi(x.w)};
                    if (gin) { x0 = x0 * rin[mm] * gv[bj][0]; x1 = x1 * rin[mm] * gv[bj][1]; }
                    const f32x4 y0 = x0 + a0 * scale, y1 = x1 + a1 * scale;
                    ss += ((y0[0] * y0[0] + y0[1] * y0[1]) + (y0[2] * y0[2] + y0[3] * y0[3])) + ((y1[0] * y1[0] + y1[1] * y1[1]) + (y1[2] * y1[2] + y1[3] * y1[3]));
                    if (part2) { const f32x4 z0 = y0 * gv[bj][0], z1 = y1 * gv[bj][1];
                        ss2 += ((z0[0] * z0[0] + z0[1] * z0[1]) + (z0[2] * z0[2] + z0[3] * z0[3])) + ((z1[0] * z1[0] + z1[1] * z1[1]) + (z1[2] * z1[2] + z1[3] * z1[3])); }
                    w.x = pg8::cvt_pk_bf16(y0[0], y0[1]); w.y = pg8::cvt_pk_bf16(y0[2], y0[3]); w.z = pg8::cvt_pk_bf16(y1[0], y1[1]); w.w = pg8::cvt_pk_bf16(y1[2], y1[3]);
                    *(u32x4*)(X + (size_t)(row0 + ai * 128 + (mb + mm) * 16) * D + col0 + bj * 128) = w;
                }
                if (part) { ss += __shfl_xor(ss, 16); ss += __shfl_xor(ss, 32); if (fq == 0) part[(size_t)(row0 + ai * 128 + (mb + mm) * 16) * 16 + u.pn * 4 + wc] = ss; }
                if (part2) { ss2 += __shfl_xor(ss2, 16); ss2 += __shfl_xor(ss2, 32); if (fq == 0) part2[(size_t)(row0 + ai * 128 + (mb + mm) * 16) * 16 + u.pn * 4 + wc] = ss2; }
            }
            asm volatile("" ::: "memory");
        }
    }
};
struct EpiQKV {
    static constexpr bool PERM = true, AFTER_DRAIN = false;
    bf16_t* QKV; int row_base; const float* qg; const float* kg; const float* rope; const LAS float* scr;
    __device__ __forceinline__ void operator()(const f32x4 (&acc)[2][2][4][2], const pg8::Unit& u, int wr, int wc, int fr, int fq) const {
        const int which = u.pn / 12;
        const int lrow0 = u.pm * 256 + wr * 64 + fr, dcol = u.pn * 256 + wc * 64 + 8 * fq;
        if (which == 2) {
#pragma unroll
            for (int ai = 0; ai < 2; ++ai)
#pragma unroll
                for (int m = 0; m < 4; ++m) {
                    bf16_t* p = QKV + (size_t)(lrow0 + ai * 128 + m * 16) * QKVW + dcol;
                    const float rsc = scr[u.idx * 256 + wr * 64 + fr + ai * 128 + m * 16];
#pragma unroll
                    for (int bj = 0; bj < 2; ++bj) { const f32x4 a = acc[ai][bj][m][0] * rsc, b = acc[ai][bj][m][1] * rsc;
                        u32x4 w; w.x = pg8::cvt_pk_bf16(a[0], a[1]); w.y = pg8::cvt_pk_bf16(a[2], a[3]); w.z = pg8::cvt_pk_bf16(b[0], b[1]); w.w = pg8::cvt_pk_bf16(b[2], b[3]);
                        *(u32x4*)(p + 32 * bj) = w; }
                }
            return;
        }
        const float* gp = which == 0 ? qg : kg; const float sc = which == 0 ? 0.125f * LOG2E : 1.0f;
#pragma unroll
        for (int ap = 0; ap < 4; ++ap) {
            const int ai = ap >> 1, mb = (ap & 1) * 2;
            f32x4 cs[2][4];
            float g1[8], g2[8];
            { const float* gpl = gp; asm volatile("" : "+v"(gpl));
#pragma unroll
              for (int i = 0; i < 8; ++i) { g1[i] = gpl[8 * fq + i] * sc; g2[i] = gpl[32 + 8 * fq + i] * sc; } }
#pragma unroll
            for (int mm = 0; mm < 2; ++mm) {
                const int grow = row_base + lrow0 + ai * 128 + (mb + mm) * 16, pos = grow < TP ? (grow & 8191) : (grow & 2047);
                const f32x4* rp = (const f32x4*)(rope + ((size_t)pos * 32 + 8 * fq) * 2);
#pragma unroll
                for (int i2 = 0; i2 < 4; ++i2) cs[mm][i2] = rp[i2];
            }
#pragma unroll
            for (int mm = 0; mm < 2; ++mm) {
                const int m = mb + mm, lrow = lrow0 + ai * 128 + m * 16;
                float a[8], b[8];
#pragma unroll
                for (int n = 0; n < 2; ++n)
#pragma unroll
                    for (int j = 0; j < 4; ++j) { a[n * 4 + j] = acc[ai][0][m][n][j]; b[n * 4 + j] = acc[ai][1][m][n][j]; }
                float ss = 0.f;
#pragma unroll
                for (int i = 0; i < 8; ++i) ss += a[i] * a[i] + b[i] * b[i];
                ss += __shfl_xor(ss, 16); ss += __shfl_xor(ss, 32);
                const float rsc = scr[u.idx * 256 + wr * 64 + fr + ai * 128 + m * 16];
                const float rinv = rsc * __builtin_amdgcn_rsqf(rsc * rsc * ss * (1.0f / 64.0f) + EPS);
                float o1[8], o2[8];
#pragma unroll
                for (int i2 = 0; i2 < 4; ++i2) { const f32x4 c4 = cs[mm][i2];
                    { const int i = 2 * i2; const float t1 = a[i] * rinv * g1[i], t2 = b[i] * rinv * g2[i]; o1[i] = t1 * c4[0] - t2 * c4[1]; o2[i] = t2 * c4[0] + t1 * c4[1]; }
                    { const int i = 2 * i2 + 1; const float t1 = a[i] * rinv * g1[i], t2 = b[i] * rinv * g2[i]; o1[i] = t1 * c4[2] - t2 * c4[3]; o2[i] = t2 * c4[2] + t1 * c4[3]; } }
                bf16_t* p = QKV + (size_t)lrow * QKVW + dcol;
                u32x4 w; w.x = pg8::cvt_pk_bf16(o1[0], o1[1]); w.y = pg8::cvt_pk_bf16(o1[2], o1[3]); w.z = pg8::cvt_pk_bf16(o1[4], o1[5]); w.w = pg8::cvt_pk_bf16(o1[6], o1[7]);
                *(u32x4*)p = w;
                w.x = pg8::cvt_pk_bf16(o2[0], o2[1]); w.y = pg8::cvt_pk_bf16(o2[2], o2[3]); w.z = pg8::cvt_pk_bf16(o2[4], o2[5]); w.w = pg8::cvt_pk_bf16(o2[6], o2[7]);
                *(u32x4*)(p + 32) = w;
            }
        }
    }
};
struct EpiSguIn {
    static constexpr bool PERM = true, AFTER_DRAIN = false;
    bf16_t* U; bf16_t* V; const float* bias; float* stats; const LAS float* scr;
    __device__ __forceinline__ void operator()(const f32x4 (&acc)[2][2][4][2], const pg8::Unit& u, int wr, int wc, int fr, int fq) const {
        const bool isv = u.pn >= 4;
        bf16_t* O = isv ? V : U;
        const int row0 = u.pm * 256 + wr * 64 + fr, dcol = (u.pn & 3) * 256 + wc * 32 + 8 * fq, bcol = u.pn * 256 + wc * 32 + 8 * fq;
        float bv[2][8];
#pragma unroll
        for (int bj = 0; bj < 2; ++bj)
#pragma unroll
            for (int i = 0; i < 8; ++i) bv[bj][i] = bias[bcol + 128 * bj + i];
#pragma unroll
        for (int ai = 0; ai < 2; ++ai)
#pragma unroll
            for (int m = 0; m < 4; ++m) {
                const int row = row0 + ai * 128 + m * 16;
                const float rsc = scr[u.idx * 256 + wr * 64 + fr + ai * 128 + m * 16];
                float s = 0.f, ss = 0.f;
#pragma unroll
                for (int bj = 0; bj < 2; ++bj) {
                    float z[8];
#pragma unroll
                    for (int n = 0; n < 2; ++n)
#pragma unroll
                        for (int j = 0; j < 4; ++j) { const float x = acc[ai][bj][m][n][j] * rsc + bv[bj][n * 4 + j];
                            const float t = x * __builtin_fmaf(x * x, 0.044715f, 1.0f);
                            const float zz = x * __builtin_amdgcn_rcpf(1.0f + __builtin_amdgcn_exp2f(t * (-2.0f * LOG2E * 0.7978845608028654f)));
                            z[n * 4 + j] = zz; s += zz; ss += zz * zz; }
                    u32x4 w; w.x = pg8::cvt_pk_bf16(z[0], z[1]); w.y = pg8::cvt_pk_bf16(z[2], z[3]); w.z = pg8::cvt_pk_bf16(z[4], z[5]); w.w = pg8::cvt_pk_bf16(z[6], z[7]);
                    *(u32x4*)(O + (size_t)row * D + dcol + 128 * bj) = w;
                }
                if (isv) {
                    s += __shfl_xor(s, 16); s += __shfl_xor(s, 32); ss += __shfl_xor(ss, 16); ss += __shfl_xor(ss, 32);
                    if (fq == 0) { f32x2_t st = {s, ss}; *(f32x2_t*)(stats + ((size_t)row * 16 + (u.pn - 4) * 4 + wc) * 2) = st; }
                }
            }
    }
};

template <int MODE>
__device__ __forceinline__ void norm_phase(const Params& P, const float* g, bool last, int gw, int ngw, int lane) {
    bf16_t* X = (bf16_t*)(P.ws + WS_H); float* R2 = (float*)(P.ws + WS_R2);
    for (int row0 = gw; row0 < T; row0 += 2 * ngw) {
        f32x4 v[2][4]; float s[2];
#pragma unroll
        for (int k = 0; k < 2; ++k) { const int row = row0 + k * ngw;
            if (MODE == 0) { const float* src = row < TP ? P.in[0] + (size_t)row * D : P.in[1] + (size_t)(row - TP) * D;
#pragma unroll
                for (int j = 0; j < 4; ++j) v[k][j] = ((const f32x4*)src)[lane + 64 * j];
            } else {
#pragma unroll
                for (int j = 0; j < 4; ++j) { const u32x2 w = ((const u32x2*)(X + (size_t)row * D))[lane + 64 * j]; v[k][j] = (f32x4){bflo(w.x), bfhi(w.x), bflo(w.y), bfhi(w.y)}; }
            } }
#pragma unroll
        for (int k = 0; k < 2; ++k) { s[k] = 0.f;
#pragma unroll
            for (int j = 0; j < 4; ++j) s[k] += (v[k][j][0] * v[k][j][0] + v[k][j][1] * v[k][j][1]) + (v[k][j][2] * v[k][j][2] + v[k][j][3] * v[k][j][3]); }
#pragma unroll
        for (int k = 0; k < 2; ++k) { const int row = row0 + k * ngw;
            float r = __builtin_amdgcn_rsqf(wave_sum(s[k]) * (1.0f / D) + EPS);
            if (MODE == 0) {
#pragma unroll
                for (int j = 0; j < 4; ++j) { u32x2 w; w.x = cvtpk(v[k][j][0], v[k][j][1]); w.y = cvtpk(v[k][j][2], v[k][j][3]); ((u32x2*)(X + (size_t)row * D))[lane + 64 * j] = w; }
            }
            if (MODE == 2) {
                float s2 = 0.f;
#pragma unroll
                for (int j = 0; j < 4; ++j) { const f32x4 gg = ((const f32x4*)g)[lane + 64 * j]; v[k][j] = v[k][j] * r * gg;
                    s2 += (v[k][j][0] * v[k][j][0] + v[k][j][1] * v[k][j][1]) + (v[k][j][2] * v[k][j][2] + v[k][j][3] * v[k][j][3]); }
                if (last) {
#pragma unroll
                    for (int j = 0; j < 4; ++j) ((f32x4*)((float*)P.out + (size_t)row * D))[lane + 64 * j] = v[k][j];
                    continue;
                }
#pragma unroll
                for (int j = 0; j < 4; ++j) { u32x2 w; w.x = cvtpk(v[k][j][0], v[k][j][1]); w.y = cvtpk(v[k][j][2], v[k][j][3]); ((u32x2*)(X + (size_t)row * D))[lane + 64 * j] = w; }
                r = __builtin_amdgcn_rsqf(wave_sum(s2) * (1.0f / D) + EPS);
            }
            if (lane == 0) R2[row] = r;
        }
    }
}

__device__ __forceinline__ void tconv(const float* W, int K, int N, bf16_t* Wt, const float* gain, int mode, int gw, int ngw, int lane, const float* gain2 = nullptr) {
    const int nbk = N / 32, items = nbk * (K / 64);
    const int kk = lane >> 3, nq = lane & 7;
    for (int it = gw; it < items; it += ngw) {
        const int nb = it % nbk, kb = it / nbk;
        const int n = nb * 32 + nq * 4, k0 = kb * 64 + kk * 8;
        int sc = n;
        if (mode == 1) { const int cc = n & 255; sc = (cc >> 7) * FF + (n >> 8) * 128 + (cc & 127); }
        else if (mode == 2) { const int cc = n & 255; sc = (n & ~255) + ((cc >> 5) & 3) * 64 + (((cc >> 7) << 5) | (cc & 31)); }
        f32x4 v[8];
#pragma unroll
        for (int i = 0; i < 8; ++i) v[i] = *(const f32x4*)(W + (size_t)(k0 + i) * N + sc);
        if (gain) {
            const f32x4 g0 = *(const f32x4*)(gain + k0), g1 = *(const f32x4*)(gain + k0 + 4);
#pragma unroll
            for (int i = 0; i < 4; ++i) { v[i] = v[i] * g0[i]; v[4 + i] = v[4 + i] * g1[i]; }
        }
        if (gain2) {
            const f32x4 g0 = *(const f32x4*)(gain2 + k0), g1 = *(const f32x4*)(gain2 + k0 + 4);
#pragma unroll
            for (int i = 0; i < 4; ++i) { v[i] = v[i] * g0[i]; v[4 + i] = v[4 + i] * g1[i]; }
        }
#pragma unroll
        for (int j = 0; j < 4; ++j) {
            u32x4 w; w.x = cvtpk(v[0][j], v[1][j]); w.y = cvtpk(v[2][j], v[3][j]); w.z = cvtpk(v[4][j], v[5][j]); w.w = cvtpk(v[6][j], v[7][j]);
            *(u32x4*)(Wt + (size_t)(n + j) * K + k0) = w;
        }
    }
}

struct WPtrs { bf16_t *f1in, *f1out, *f2in, *f2out, *qkv, *wo, *sin, *sout, *wsp; };
__device__ __forceinline__ WPtrs wptrs(unsigned char* ws, int layer) {
    bf16_t* w = (bf16_t*)(ws + WS_W); WPtrs r;
    bf16_t* l = w + (size_t)layer * E_LAYER; r.f1in = l; r.f1out = l + E_FIN; r.f2in = l + E_FIN + E_FOUT; r.f2out = l + 2 * E_FIN + E_FOUT;
    bf16_t* a = w + DEPTH * E_LAYER + (size_t)(layer >> 1) * E_ATT; r.qkv = a; r.wo = a + E_QKV;
    bf16_t* s = w + DEPTH * E_LAYER + 2 * E_ATT + (size_t)(layer >> 1) * E_SGU; r.sin = s; r.sout = s + E_SIN; r.wsp = s + E_SIN + E_SOUT;
    return r;
}

__device__ __forceinline__ void prologue_phase(const Params& P, int gw, int ngw, int lane) {
    const int gt = gw * 64 + lane, ngt = ngw * 64;
    { float* rope = (float*)(P.ws + WS_ROPE);
      for (int i = gt; i < 8192 * 32; i += ngt) { const int pos = i >> 5, f = i & 31; const float inv = powf(10000.0f, -(float)f / 32.0f); const float ang = (float)pos * inv;
          rope[2 * i] = cosf(ang); rope[2 * i + 1] = sinf(ang); } }
    { float* W1 = (float*)(P.ws + WS_W1);
      for (int i = gt; i < 2 * 1024; i += ngt) { const float* s = P.in[14] + (size_t)i * 128; float a = 0.f;
          for (int q2 = 0; q2 < 64; ++q2) { const unsigned w = cvtpk(s[2 * q2], s[2 * q2 + 1]); a += bflo(w) + bfhi(w); }
          W1[i] = a; } }
    for (int l = 0; l < DEPTH; ++l) {
        const WPtrs w = wptrs(P.ws, l);
        tconv(P.in[3] + (size_t)l * D * 2 * FF, D, 2 * FF, w.f1in, P.in[2] + l * D, 1, gw, ngw, lane, l > 0 ? P.in[20] + (l - 1) * D : nullptr);
        tconv(P.in[4] + (size_t)l * FF * D, FF, D, w.f1out, nullptr, 0, gw, ngw, lane);
        tconv(P.in[18] + (size_t)l * D * 2 * FF, D, 2 * FF, w.f2in, P.in[17] + l * D, 1, gw, ngw, lane);
        tconv(P.in[19] + (size_t)l * FF * D, FF, D, w.f2out, nullptr, 0, gw, ngw, lane);
        const int j = l >> 1;
        if ((l & 1) == 0) {
            tconv(P.in[6] + (size_t)j * D * QKVW, D, QKVW, w.qkv, P.in[5] + l * D, 2, gw, ngw, lane);
            tconv(P.in[9] + (size_t)j * D * D, D, D, w.wo, nullptr, 0, gw, ngw, lane);
        } else {
            tconv(P.in[10] + (size_t)j * D * 2 * D, D, 2 * D, w.sin, P.in[5] + l * D, 0, gw, ngw, lane);
            tconv(P.in[16] + (size_t)j * D * D, D, D, w.sout, nullptr, 0, gw, ngw, lane);
            const float* s = P.in[14] + (size_t)j * E_WS;
            for (int i = gt; i < (int)E_WS / 2; i += ngt) ((unsigned*)w.wsp)[i] = cvtpk(s[2 * i], s[2 * i + 1]);
        }
    }
    norm_phase<0>(P, nullptr, false, gw, ngw, lane);
}

__device__ __forceinline__ void attn_unit(unsigned lbase, LAS unsigned char* vl, const bf16_t* qkv, bf16_t* og, float* lse, int seq_row0, int d, int r, int L, int m0, int g, int h, int lane, int variant) {
    const int qi = lane & 31, hi = lane >> 5;
    const int mq = m0 + qi;
    const size_t qrow = (size_t)(seq_row0 + mq * d + r);
    bf16x8 qf[4];
    { const bf16_t* qp = qkv + qrow * QKVW + g * 1024 + h * 64 + 8 * hi;
#pragma unroll
      for (int ks = 0; ks < 4; ++ks) qf[ks] = *(const bf16x8*)(qp + 16 * ks); }
    const bf16_t* kcol = qkv + 3072 + g * 1024 + h * 64 + 8 * hi;
    bf16x8 kf[5][4];
#pragma unroll
    for (int j = 0; j < 5; ++j) {
        int mk = m0 - 64 + 32 * j + qi; mk = mk < 0 ? 0 : (mk > L - 1 ? L - 1 : mk);
        const bf16_t* kp = kcol + (size_t)(seq_row0 + mk * d + r) * QKVW;
#pragma unroll
        for (int ks = 0; ks < 4; ++ks) kf[j][ks] = *(const bf16x8*)(kp + 16 * ks);
    }
    f32x16 s[5];
#pragma unroll
    for (int j = 0; j < 5; ++j) {
        f32x16 a;
#pragma unroll
        for (int i = 0; i < 16; ++i) a[i] = 0.f;
#pragma unroll
        for (int ks = 0; ks < 4; ++ks) a = MFMA32(kf[j][ks], qf[ks], a);
        s[j] = a;
    }
    if (variant == 3) { float t = 0.f; for (int j = 0; j < 5; ++j) t += s[j][0] + s[j][15]; if (t == 12345.678f) lse[qrow * 16 + h] = t; return; }
    const bf16_t* vcol = qkv + 6144 + g * 1024 + h * 64 + (lane & 7) * 8;
    u32x4 vv[5][4];
#pragma unroll
    for (int j = 0; j < 5; ++j)
#pragma unroll
        for (int i = 0; i < 4; ++i) { int mk = m0 - 64 + 32 * j + (lane >> 3) + 8 * i; mk = mk < 0 ? 0 : (mk > L - 1 ? L - 1 : mk);
            vv[j][i] = *(const u32x4*)(vcol + (size_t)(seq_row0 + mk * d + r) * QKVW); }
    float mx = -INFINITY;
    if (m0 - 64 >= 0 && m0 + 96 <= L) {
#pragma unroll
        for (int rr = 0; rr < 16; ++rr) { const int kin = 8 * (rr >> 2) + 4 * hi + (rr & 3);
            s[0][rr] = kin >= qi ? s[0][rr] : -INFINITY; s[4][rr] = kin <= qi ? s[4][rr] : -INFINITY; }
    } else {
#pragma unroll
        for (int j = 0; j < 5; ++j)
#pragma unroll
            for (int rr = 0; rr < 16; ++rr) {
                const int kin = 8 * (rr >> 2) + 4 * hi + (rr & 3), mk = m0 - 64 + 32 * j + kin, df = mk - mq;
                const bool valid = (mk >= 0) && (mk < L) && (df >= -64) && (df <= 64);
                s[j][rr] = valid ? s[j][rr] : -INFINITY;
            }
    }
#pragma unroll
    for (int j = 0; j < 5; ++j)
#pragma unroll
        for (int rr = 0; rr < 16; ++rr) mx = fmaxf(mx, s[j][rr]);
    mx = fmaxf(mx, __shfl_xor(mx, 32));
    float l = 0.f;
#pragma unroll
    for (int j = 0; j < 5; ++j)
#pragma unroll
        for (int rr = 0; rr < 16; ++rr) { const float p = __builtin_amdgcn_exp2f(s[j][rr] - mx); s[j][rr] = p; l += p; }
    l += __shfl_xor(l, 32);
    if (variant == 2) { if (l == 12345.678f) lse[qrow * 16 + h] = l + mx; return; }
    f32x16 o[2];
#pragma unroll
    for (int i = 0; i < 16; ++i) { o[0][i] = 0.f; o[1][i] = 0.f; }
    const int i16 = lane & 15;
    const unsigned la = lbase + (unsigned)((4 * hi + (i16 >> 2)) * 192 + (16 * ((lane >> 4) & 1) + 4 * (i16 & 3)) * 2);
#pragma unroll
    for (int j = 0; j < 5; ++j) {
#pragma unroll
        for (int i = 0; i < 4; ++i) *(LAS u32x4*)(vl + ((lane >> 3) + 8 * i) * 192 + (lane & 7) * 16) = vv[j][i];
        s16x4 t[8];
#define TRRD(dst, off) asm volatile("ds_read_b64_tr_b16 %0, %1 offset:%2" : "=&v"(dst) : "v"(la), "i"(off) : "memory")
        TRRD(t[0], 0); TRRD(t[1], 8 * 192); TRRD(t[2], 64); TRRD(t[3], 8 * 192 + 64);
        TRRD(t[4], 16 * 192); TRRD(t[5], 24 * 192); TRRD(t[6], 16 * 192 + 64); TRRD(t[7], 24 * 192 + 64);
        asm volatile("s_waitcnt lgkmcnt(0)" : "+v"(t[0]), "+v"(t[1]), "+v"(t[2]), "+v"(t[3]), "+v"(t[4]), "+v"(t[5]), "+v"(t[6]), "+v"(t[7]) :: "memory");
#pragma unroll
        for (int s2 = 0; s2 < 2; ++s2) {
            u32x4 pw; pw.x = cvtpk(s[j][8 * s2 + 0], s[j][8 * s2 + 1]); pw.y = cvtpk(s[j][8 * s2 + 2], s[j][8 * s2 + 3]); pw.z = cvtpk(s[j][8 * s2 + 4], s[j][8 * s2 + 5]); pw.w = cvtpk(s[j][8 * s2 + 6], s[j][8 * s2 + 7]);
            const bf16x8 pb = __builtin_bit_cast(bf16x8, pw);
#pragma unroll
            for (int mt = 0; mt < 2; ++mt) {
                const bf16x8 va = __builtin_shufflevector(t[4 * s2 + 2 * mt], t[4 * s2 + 2 * mt + 1], 0, 1, 2, 3, 4, 5, 6, 7);
                o[mt] = MFMA32(va, pb, o[mt]);
            }
        }
    }
    if (variant == 1) { if (o[0][0] + o[1][5] == 12345.678f) lse[qrow * 16 + h] = l; return; }
    const float inv = 1.0f / l;
#pragma unroll
    for (int mt = 0; mt < 2; ++mt)
#pragma unroll
        for (int g4 = 0; g4 < 4; ++g4) { u32x2 w; w.x = cvtpk(o[mt][4 * g4] * inv, o[mt][4 * g4 + 1] * inv); w.y = cvtpk(o[mt][4 * g4 + 2] * inv, o[mt][4 * g4 + 3] * inv);
            *(LAS u32x2*)(vl + qi * 144 + (32 * mt + 8 * g4 + 4 * hi) * 2) = w; }
#pragma unroll
    for (int i = 0; i < 4; ++i) { const int qq = (lane >> 3) + 8 * i;
        const u32x4 w = *(const LAS u32x4*)(vl + qq * 144 + (lane & 7) * 16);
        *(u32x4*)(og + (size_t)(seq_row0 + (m0 + qq) * d + r) * D + h * 64 + (lane & 7) * 8) = w; }
    if (hi == 0) lse[qrow * 16 + h] = mx + __builtin_amdgcn_logf(l);
}

__device__ __forceinline__ void attn_phase(const Params& P, LAS unsigned char* lds, int chunk, int gw, int ngw, int wave, int lane, int variant) {
    const bf16_t* qkv = (const bf16_t*)(P.ws + WS_BIG);
    bf16_t* og = (bf16_t*)(P.ws + WS_BIG + BIG_OG);
    float* lse = (float*)(P.ws + WS_LSE);
    LAS unsigned char* vl = lds + wave * 6144;
    const unsigned lbase = (unsigned)(size_t)vl;
    const int S = chunk < 2 ? 8192 : 2048;
    for (int u = gw; u < 3 * 16 * (CH / 32); u += ngw) {
        const int g = u / 4096, rem = u % 4096, h = rem / 256, rem2 = rem % 256;
        const int d = g == 0 ? 1 : (g == 1 ? 4 : 16);
        const int bps = S / 32, seq = rem2 / bps, rem3 = rem2 % bps, L = S / d, bpr = L / 32, r = rem3 / bpr, blk = rem3 % bpr;
        attn_unit(lbase, vl, qkv, og + (size_t)g * CH * D, lse + (size_t)g * CH * 16, seq * S, d, r, L, blk * 32, g, h, lane, variant);
    }
}

struct CoopUnit { int seq_row0, d, r, L, m0, g, h, ncls; };
__device__ __forceinline__ CoopUnit coop_decode(int bu, int S) {
    CoopUnit c; c.g = bu / 512; const int rem = bu % 512; c.h = rem / 32; const int sp = rem % 32;
    c.d = c.g == 0 ? 1 : (c.g == 1 ? 4 : 16); c.L = S / c.d;
    const int sps = S / 256, seq = sp / sps, rem2 = sp % sps; c.seq_row0 = seq * S;
    if (c.L >= 256) { const int spc = c.L / 256; c.r = rem2 / spc; c.m0 = 256 * (rem2 % spc); c.ncls = 1; }
    else { c.r = 2 * rem2; c.m0 = 0; c.ncls = 2; }
    return c;
}
__device__ __forceinline__ long coop_piece(const CoopUnit& c, int p) {
    const int slot = p >> 8, row = (p >> 3) & 31, ch = p & 7;
    int kb, cls = 0;
    if (c.ncls == 1) kb = c.m0 - 64 + 32 * slot; else { if (slot >= 8) return -1; cls = slot >> 2; kb = 32 * (slot & 3); }
    if (kb < 0 || kb >= c.L) return -1;
    return (long)(c.seq_row0 + (kb + row) * c.d + c.r + cls) * QKVW + c.g * 1024 + c.h * 64 + ch * 8;
}
__device__ __forceinline__ void coop_qload(const CoopUnit& c, const bf16_t* qkv, int wave, int qi, int hi, bf16x8 (&qf)[4]) {
    const int cls = c.ncls == 2 ? (wave >> 2) : 0, qb = c.ncls == 2 ? (wave & 3) : wave;
    const bf16_t* qp = qkv + (size_t)(c.seq_row0 + (c.m0 + 32 * qb + qi) * c.d + c.r + cls) * QKVW + c.g * 1024 + c.h * 64 + 8 * hi;
#pragma unroll
    for (int ks = 0; ks < 4; ++ks) qf[ks] = *(const bf16x8*)(qp + 16 * ks);
}
constexpr int CO_K = 0, CO_V = 12 * 4608;

__device__ __forceinline__ void attn_phase_coop(const Params& P, LAS unsigned char* lds, int chunk, int bid, int G, int tid, int wave, int lane, int variant) {
    const bf16_t* qkv = (const bf16_t*)(P.ws + WS_BIG);
    bf16_t* ogb = (bf16_t*)(P.ws + WS_BIG + BIG_OG);
    float* lseb = (float*)(P.ws + WS_LSE);
    const int S = chunk < 2 ? 8192 : 2048;
    const int NBU = 3 * 16 * (CH / 256);
    const int qi = lane & 31, hi = lane >> 5, i16 = lane & 15;
    u32x4 pk[6], pv[6]; bf16x8 qn[4];
    int bu = (G % 8 == 0) ? (bid % 8) * (G / 8) + bid / 8 : bid;
    if (bu < NBU) { const CoopUnit c = coop_decode(bu, S); coop_qload(c, qkv, wave, qi, hi, qn);
#pragma unroll
        for (int i = 0; i < 6; ++i) { const long o = coop_piece(c, tid + NTHR * i); pk[i] = (u32x4){0u, 0u, 0u, 0u}; pv[i] = pk[i];
            if (o >= 0) { pk[i] = *(const u32x4*)(qkv + 3072 + o); pv[i] = *(const u32x4*)(qkv + 6144 + o); } } }
    for (; bu < NBU; bu += G) {
        const CoopUnit c = coop_decode(bu, S);
        int t2 = tid; asm volatile("" : "+v"(t2));
#pragma unroll
        for (int i = 0; i < 6; ++i) { const int p = t2 + NTHR * i, slot = p >> 8, row = (p >> 3) & 31, ch = p & 7;
            *(LAS u32x4*)(lds + CO_K + slot * 4608 + row * 144 + ch * 16) = pk[i];
            *(LAS u32x4*)(lds + CO_V + slot * 6144 + row * 192 + ch * 16) = pv[i]; }
        __syncthreads();
        if (bu + G < NBU) { const CoopUnit cn = coop_decode(bu + G, S);
            int t3 = tid; asm volatile("" : "+v"(t3));
#pragma unroll
            for (int i = 0; i < 6; ++i) { const long o = coop_piece(cn, t3 + NTHR * i); pk[i] = (u32x4){0u, 0u, 0u, 0u}; pv[i] = pk[i];
                if (o >= 0) { pk[i] = *(const u32x4*)(qkv + 3072 + o); pv[i] = *(const u32x4*)(qkv + 6144 + o); } } }
        const int cls = c.ncls == 2 ? (wave >> 2) : 0, qb = c.ncls == 2 ? (wave & 3) : wave;
        const int mq = c.m0 + 32 * qb + qi;
        const size_t qrow = (size_t)(c.seq_row0 + mq * c.d + c.r + cls);
        f32x16 s[5]; int slotj[5]; bool vj[5];
#pragma unroll
        for (int j = 0; j < 5; ++j) {
            const int t = qb + j, kb = c.m0 - 64 + 32 * t;
            vj[j] = (kb >= 0) && (kb < c.L); slotj[j] = c.ncls == 2 ? cls * 4 + (t - 2) : t;
            f32x16 a;
#pragma unroll
            for (int i = 0; i < 16; ++i) a[i] = vj[j] ? 0.f : -INFINITY;
            if (vj[j]) {
                const LAS unsigned char* kp = lds + CO_K + slotj[j] * 4608 + qi * 144 + hi * 16;
#pragma unroll
                for (int ks = 0; ks < 4; ++ks) { const bf16x8 kf = *(const LAS bf16x8*)(kp + ks * 32); a = MFMA32(kf, qn[ks], a); }
            }
            s[j] = a;
        }
        if (bu + G < NBU) { const CoopUnit cn = coop_decode(bu + G, S); coop_qload(cn, qkv, wave, qi, hi, qn); }
#pragma unroll
        for (int rr = 0; rr < 16; ++rr) { const int kin = 8 * (rr >> 2) + 4 * hi + (rr & 3);
            s[0][rr] = kin >= qi ? s[0][rr] : -INFINITY; s[4][rr] = kin <= qi ? s[4][rr] : -INFINITY; }
        float mx = -INFINITY;
#pragma unroll
        for (int j = 0; j < 5; ++j)
#pragma unroll
            for (int rr = 0; rr < 16; ++rr) mx = fmaxf(mx, s[j][rr]);
        mx = fmaxf(mx, __shfl_xor(mx, 32));
        float l = 0.f;
#pragma unroll
        for (int j = 0; j < 5; ++j)
#pragma unroll
            for (int rr = 0; rr < 16; ++rr) { const float p = __builtin_amdgcn_exp2f(s[j][rr] - mx); s[j][rr] = p; l += p; }
        l += __shfl_xor(l, 32);
        f32x16 o[2];
#pragma unroll
        for (int i = 0; i < 16; ++i) { o[0][i] = 0.f; o[1][i] = 0.f; }
        const unsigned lav = (unsigned)(size_t)(lds + CO_V) + (unsigned)((4 * hi + (i16 >> 2)) * 192 + (16 * ((lane >> 4) & 1) + 4 * (i16 & 3)) * 2);
        unsigned laj[5];
#pragma unroll
        for (int j = 0; j < 5; ++j) laj[j] = lav + (unsigned)(vj[j] ? slotj[j] : 0) * 6144u;
        s16x4 ta[8], tb[8];
#define TRRDC(dst, LA, off) asm volatile("ds_read_b64_tr_b16 %0, %1 offset:%2" : "=&v"(dst) : "v"(LA), "i"(off) : "memory")
#define TR_ISSUE(T, LA) do { TRRDC(T[0], LA, 0); TRRDC(T[1], LA, 8 * 192); TRRDC(T[2], LA, 64); TRRDC(T[3], LA, 8 * 192 + 64); \
                             TRRDC(T[4], LA, 16 * 192); TRRDC(T[5], LA, 24 * 192); TRRDC(T[6], LA, 16 * 192 + 64); TRRDC(T[7], LA, 24 * 192 + 64); } while (0)
#define TR_WAIT(N, T) asm volatile("s_waitcnt lgkmcnt(" #N ")" : "+v"(T[0]), "+v"(T[1]), "+v"(T[2]), "+v"(T[3]), "+v"(T[4]), "+v"(T[5]), "+v"(T[6]), "+v"(T[7]) :: "memory")
#define PV_TILE(J, T) do { _Pragma("unroll") for (int s2 = 0; s2 < 2; ++s2) { \
            u32x4 pw; pw.x = cvtpk(s[J][8 * s2 + 0], s[J][8 * s2 + 1]); pw.y = cvtpk(s[J][8 * s2 + 2], s[J][8 * s2 + 3]); pw.z = cvtpk(s[J][8 * s2 + 4], s[J][8 * s2 + 5]); pw.w = cvtpk(s[J][8 * s2 + 6], s[J][8 * s2 + 7]); \
            const bf16x8 pb = __builtin_bit_cast(bf16x8, pw); \
            _Pragma("unroll") for (int mt = 0; mt < 2; ++mt) { \
                const bf16x8 va = __builtin_shufflevector(T[4 * s2 + 2 * mt], T[4 * s2 + 2 * mt + 1], 0, 1, 2, 3, 4, 5, 6, 7); \
                o[mt] = MFMA32(va, pb, o[mt]); } } } while (0)
        TR_ISSUE(ta, laj[0]);
        TR_ISSUE(tb, laj[1]); TR_WAIT(8, ta); PV_TILE(0, ta);
        TR_ISSUE(ta, laj[2]); TR_WAIT(8, tb); PV_TILE(1, tb);
        TR_ISSUE(tb, laj[3]); TR_WAIT(8, ta); PV_TILE(2, ta);
        TR_ISSUE(ta, laj[4]); TR_WAIT(8, tb); PV_TILE(3, tb);
        TR_WAIT(0, ta); PV_TILE(4, ta);
        __syncthreads();
        const float inv = 1.0f / l;
        LAS unsigned char* vl = lds + CO_K + wave * 4608;
#pragma unroll
        for (int mt = 0; mt < 2; ++mt)
#pragma unroll
            for (int g4 = 0; g4 < 4; ++g4) { u32x2 w; w.x = cvtpk(o[mt][4 * g4] * inv, o[mt][4 * g4 + 1] * inv); w.y = cvtpk(o[mt][4 * g4 + 2] * inv, o[mt][4 * g4 + 3] * inv);
                *(LAS u32x2*)(vl + qi * 144 + (32 * mt + 8 * g4 + 4 * hi) * 2) = w; }
        bf16_t* og = ogb + (size_t)c.g * CH * D; float* lse = lseb + (size_t)c.g * CH * 16;
#pragma unroll
        for (int i = 0; i < 4; ++i) { const int qq = (lane >> 3) + 8 * i;
            const u32x4 w = *(const LAS u32x4*)(vl + qq * 144 + (lane & 7) * 16);
            *(u32x4*)(og + (size_t)(c.seq_row0 + (c.m0 + 32 * qb + qq) * c.d + c.r + cls) * D + c.h * 64 + (lane & 7) * 8) = w; }
        if (hi == 0) lse[qrow * 16 + c.h] = mx + __builtin_amdgcn_logf(l);
        __syncthreads();
    }
    (void)variant;
}

__device__ __forceinline__ void combine_phase(const Params& P, int chunk, int gt, int ngt) {
    const bf16_t* og = (const bf16_t*)(P.ws + WS_BIG + BIG_OG);
    const float* lse = (const float*)(P.ws + WS_LSE);
    bf16_t* H = (bf16_t*)P.out + (size_t)chunk * CH * D;
    for (int i = gt; i < CH * 128; i += ngt) {
        const int row = i >> 7, c8 = i & 127, h = c8 >> 3;
        const float l0 = lse[(size_t)row * 16 + h], l1 = lse[(size_t)(CH + row) * 16 + h], l2 = lse[(size_t)(2 * CH + row) * 16 + h];
        const float m = fmaxf(l0, fmaxf(l1, l2));
        float w0 = __builtin_amdgcn_exp2f(l0 - m), w1 = __builtin_amdgcn_exp2f(l1 - m), w2 = __builtin_amdgcn_exp2f(l2 - m);
        const float inv = 1.0f / (w0 + w1 + w2); w0 *= inv; w1 *= inv; w2 *= inv;
        const u32x4 a = *(const u32x4*)(og + (size_t)row * D + c8 * 8), b = *(const u32x4*)(og + (size_t)(CH + row) * D + c8 * 8), c = *(const u32x4*)(og + (size_t)(2 * CH + row) * D + c8 * 8);
        u32x4 o;
#pragma unroll
        for (int k = 0; k < 4; ++k) o[k] = cvtpk(w0 * bflo(a[k]) + w1 * bflo(b[k]) + w2 * bflo(c[k]), w0 * bfhi(a[k]) + w1 * bfhi(b[k]) + w2 * bfhi(c[k]));
        *(u32x4*)(H + (size_t)row * D + c8 * 8) = o;
    }
}

__device__ __forceinline__ void spatial_phase(const Params& P, LAS unsigned char* lds, int layer, int tid, int wave, int lane, int bid, int G) {
    const int j = layer >> 1;
    bf16_t* U = (bf16_t*)(P.ws + WS_BIG); const bf16_t* V = (const bf16_t*)(P.ws + WS_BIG + BIG_V);
    const float* stats = (const float*)(P.ws + WS_BIG + BIG_ST);
    const bf16_t* wsp = wptrs(P.ws, layer).wsp;
    const float* bs = P.in[15] + j * 8 * 128; const float* lng = P.in[12] + j * D; const float* lnb = P.in[13] + j * D;
    const unsigned lb = (unsigned)(size_t)lds;
    const int hi = lane >> 5, i16 = lane & 15, pb = (wave & 3) * 32, chh = (wave >> 2) * 64;
    const unsigned la = lb + (unsigned)((8 * hi + (i16 >> 2)) * 320 + (chh + 16 * ((lane >> 4) & 1) + 4 * (i16 & 3)) * 2);
    const float* W1 = (const float*)(P.ws + WS_W1) + j * 1024;
    for (int unit = (G % 8 == 0) ? (bid % 8) * (G / 8) + bid / 8 : bid; unit < (T / 128) * 8; unit += G) {
        const int n = unit >> 3, g = unit & 7;
        const int q = tid >> 2, part = tid & 3; const size_t tok = (size_t)n * 128 + q;
        const f32x4 st0 = *(const f32x4*)(stats + tok * 32 + 8 * part), st1 = *(const f32x4*)(stats + tok * 32 + 8 * part + 4);
        const int c0 = g * 128 + part * 32;
        u32x4 vv[4];
#pragma unroll
        for (int k = 0; k < 4; ++k) vv[k] = *(const u32x4*)(V + tok * D + c0 + 8 * k);
        const bf16_t* ap = wsp + ((size_t)g * 128 + pb + (lane & 31)) * 128 + 8 * hi;
        bf16x8 af[8];
#pragma unroll
        for (int s = 0; s < 8; ++s) af[s] = *(const bf16x8*)(ap + 16 * s);
        unsigned short uu[2][16]; float bsv[16], w1v[16], lgv[2], lbv[2];
#pragma unroll
        for (int rr = 0; rr < 16; ++rr) { const int p = pb + 8 * (rr >> 2) + 4 * hi + (rr & 3); bsv[rr] = bs[g * 128 + p]; w1v[rr] = W1[g * 128 + p]; }
#pragma unroll
        for (int nt = 0; nt < 2; ++nt) { const int c = chh + 32 * nt + (lane & 31); lgv[nt] = lng[g * 128 + c]; lbv[nt] = lnb[g * 128 + c];
#pragma unroll
            for (int rr = 0; rr < 16; ++rr) { const int p = pb + 8 * (rr >> 2) + 4 * hi + (rr & 3); uu[nt][rr] = U[((size_t)n * 128 + p) * D + g * 128 + c]; } }
        { float s1 = (st0[0] + st0[2]) + (st1[0] + st1[2]), s2 = (st0[1] + st0[3]) + (st1[1] + st1[3]);
          s1 += __shfl_xor(s1, 1); s1 += __shfl_xor(s1, 2); s2 += __shfl_xor(s2, 1); s2 += __shfl_xor(s2, 2);
          const float mean = s1 * (1.0f / D), var = s2 * (1.0f / D) - mean * mean, rstd = __builtin_amdgcn_rsqf(fmaxf(var, 0.f) + EPS);
#pragma unroll
          for (int k = 0; k < 4; ++k) { const u32x4 v = vv[k]; u32x4 w;
              w.x = cvtpk((bflo(v.x) - mean) * rstd, (bfhi(v.x) - mean) * rstd); w.y = cvtpk((bflo(v.y) - mean) * rstd, (bfhi(v.y) - mean) * rstd);
              w.z = cvtpk((bflo(v.z) - mean) * rstd, (bfhi(v.z) - mean) * rstd); w.w = cvtpk((bflo(v.w) - mean) * rstd, (bfhi(v.w) - mean) * rstd);
              *(LAS u32x4*)(lds + q * 320 + (part * 32 + 8 * k) * 2) = w; } }
        __syncthreads();
        f32x16 acc[2];
#pragma unroll
        for (int i = 0; i < 16; ++i) { acc[0][i] = 0.f; acc[1][i] = 0.f; }
        s16x4 ta[4], tb[4];
#define TRRD2(dst, off) asm volatile("ds_read_b64_tr_b16 %0, %1 offset:%2" : "=&v"(dst) : "v"(la), "i"(off) : "memory")
#define SP_ISSUE(T, S) do { TRRD2(T[0], (S) * 16 * 320); TRRD2(T[1], (S) * 16 * 320 + 4 * 320); TRRD2(T[2], (S) * 16 * 320 + 64); TRRD2(T[3], (S) * 16 * 320 + 4 * 320 + 64); } while (0)
#define SP_WAIT(N, T) asm volatile("s_waitcnt lgkmcnt(" #N ")" : "+v"(T[0]), "+v"(T[1]), "+v"(T[2]), "+v"(T[3]) :: "memory")
#define SP_MMA(S, T) do { _Pragma("unroll") for (int nt = 0; nt < 2; ++nt) { const bf16x8 b = __builtin_shufflevector(T[2 * nt], T[2 * nt + 1], 0, 1, 2, 3, 4, 5, 6, 7); acc[nt] = MFMA32(af[S], b, acc[nt]); } } while (0)
        SP_ISSUE(ta, 0);
        SP_ISSUE(tb, 1); SP_WAIT(4, ta); SP_MMA(0, ta);
        SP_ISSUE(ta, 2); SP_WAIT(4, tb); SP_MMA(1, tb);
        SP_ISSUE(tb, 3); SP_WAIT(4, ta); SP_MMA(2, ta);
        SP_ISSUE(ta, 4); SP_WAIT(4, tb); SP_MMA(3, tb);
        SP_ISSUE(tb, 5); SP_WAIT(4, ta); SP_MMA(4, ta);
        SP_ISSUE(ta, 6); SP_WAIT(4, tb); SP_MMA(5, tb);
        SP_ISSUE(tb, 7); SP_WAIT(4, ta); SP_MMA(6, ta);
        SP_WAIT(0, tb); SP_MMA(7, tb);
#pragma unroll
        for (int nt = 0; nt < 2; ++nt)
#pragma unroll
            for (int rr = 0; rr < 16; ++rr) {
                const int p = pb + 8 * (rr >> 2) + 4 * hi + (rr & 3), c = chh + 32 * nt + (lane & 31);
                const float uv = __builtin_bit_cast(float, (unsigned)uu[nt][rr] << 16) * (lgv[nt] * acc[nt][rr] + (lbv[nt] * w1v[rr] + bsv[rr]));
                U[((size_t)n * 128 + p) * D + g * 128 + c] = (bf16_t)(cvtpk(uv, 0.f) & 0xffffu);
            }
        __syncthreads();
    }
}

#ifndef PER_PHASE_LAUNCH
#define PER_PHASE_LAUNCH 0
#endif
constexpr int N_PHASES = 1 + 2 * (18 + 7) + 1;

__device__ __forceinline__ void rowscale_prepass(LAS float* tab, const float* __restrict__ part, const float* __restrict__ r2, int M, int N, int row_base, int tid, int bid, int G, int wgm, const float* __restrict__ partg = nullptr, int rev = 0) {
    pg8::StaticOrder S; S.init(M, N, G, bid, rev, wgm); pg8::Unit u;
    int nu = 0; while (S.next(nu, u)) ++nu;
    for (int it0 = tid; it0 < nu * 256; it0 += 4 * NTHR) {
        float v[4];
#pragma unroll
        for (int k = 0; k < 4; ++k) { const int it = it0 + k * NTHR; v[k] = 0.f;
            if (it < nu * 256) { S.next(it >> 8, u); const size_t row = (size_t)(row_base + u.pm * 256 + (it & 255));
                if (part) { const f32x4* p = (const f32x4*)(part + row * 16); const f32x4 a = p[0], b = p[1], c = p[2], d = p[3];
                    const float s = ((a[0] + a[1]) + (a[2] + a[3])) + ((b[0] + b[1]) + (b[2] + b[3])) + (((c[0] + c[1]) + (c[2] + c[3])) + ((d[0] + d[1]) + (d[2] + d[3])));
                    v[k] = __builtin_amdgcn_rsqf(s * (1.0f / D) + EPS);
                    if (partg) {
                        const f32x4* pg = (const f32x4*)(partg + row * 16); const f32x4 e = pg[0], f = pg[1], g = pg[2], h = pg[3];
                        const float s2 = ((e[0] + e[1]) + (e[2] + e[3])) + ((f[0] + f[1]) + (f[2] + f[3])) + (((g[0] + g[1]) + (g[2] + g[3])) + ((h[0] + h[1]) + (h[2] + h[3])));
                        v[k] = v[k] * __builtin_amdgcn_rsqf(v[k] * v[k] * s2 * (1.0f / D) + EPS); } }
                else v[k] = r2[row]; } }
#pragma unroll
        for (int k = 0; k < 4; ++k) { const int it = it0 + k * NTHR; if (it < nu * 256) tab[it] = v[k]; }
    }
    __syncthreads();
}
template <class Epi>
__device__ __forceinline__ void run_gemm(LAS unsigned char* lds, const bf16_t* A, const bf16_t* Bt, int M, int N, int K, const Epi& E, int bid, int G, int tid, int wgm, int rev = 0) {
    pg8::Gemm g{A, Bt, M, N, K}; pg8::StaticOrder S; S.init(M, N, G, bid, rev, wgm);
    pg8::gemm_phase<Epi, pg8::StaticOrder, true, true>(lds, g, S, E, tid);
}

__global__ void __launch_bounds__(NTHR, 2) mega_fwd(Params P) {
    __shared__ __attribute__((aligned(16))) unsigned char lds_raw[pg8::STAGE_BYTES];
    LAS unsigned char* lds = (LAS unsigned char*)lds_raw;
    __shared__ float scr_tab[17 * 256];
    __shared__ uint4 xb_words;
    cg::grid_group grid = cg::this_grid();
    const int lo = P.ph_lo, hi = P.ph_hi;
    const int wave_s = __builtin_amdgcn_readfirstlane(threadIdx.x >> 6);
    if (threadIdx.x == 0) xb_words = make_uint4(0u, 0u, 0u, 0u);
    __syncthreads();
    XcdBarrier xbar = xcd_barrier_post((unsigned*)P.ws, (volatile LAS unsigned*)&xb_words);
#ifndef PROBE_KIND
#define PROBE_KIND (-1)
#endif
#ifndef WGM_FIN
#define WGM_FIN 4
#endif
#ifndef WGM_RES
#define WGM_RES 4
#endif
#ifndef WGM_QKV
#define WGM_QKV 4
#endif
#ifndef WGM_SIN
#define WGM_SIN 4
#endif
#ifndef PROBE_VAR
#define PROBE_VAR 0
#endif
#pragma nounroll
    for (int st = 2 * lo; st < 2 * hi; ++st) {
        const int pi = st >> 1, rep = st & 1;
        int wsl = wave_s; asm volatile("" : "+s"(wsl));
        int tid = wsl * 64 + (int)__builtin_amdgcn_mbcnt_hi(~0u, __builtin_amdgcn_mbcnt_lo(~0u, 0u)); asm volatile("" : "+v"(tid));
        int bid = blockIdx.x; asm volatile("" : "+s"(bid));
        int G = gridDim.x; asm volatile("" : "+s"(G));
        Params Q = P;
        { unsigned char* t = P.ws; asm volatile("" : "+s"(t)); Q.ws = t; float* o = P.out; asm volatile("" : "+s"(o)); Q.out = o; }
#define LANE() ({ int _l = tid & 63; asm volatile("" : "+v"(_l)); _l; })
        const int wave = wsl;
        const int gw = bid * NWAVES + wave, ngw = G * NWAVES, gt = bid * NTHR + tid, ngt = G * NTHR;
        bf16_t* H = (bf16_t*)Q.out;
        bf16_t* BIG = (bf16_t*)(Q.ws + WS_BIG);
        bf16_t* X = (bf16_t*)(Q.ws + WS_H);
        int kind = 0, l = 0, c = 0, f = 0;
        if (pi == N_PHASES - 1) { kind = 11; l = DEPTH - 1; }
        else if (pi > 0) {
            const int q = pi - 1, pair = q / 25, rq = q % 25;
            int loc;
            if (rq < 18) { l = 2 * pair; loc = rq; } else { l = 2 * pair + 1; loc = rq - 18; }
            const int tail = (l & 1) ? 5 : 16;
            if (loc == 0) { kind = 1; f = 0; } else if (loc == 1) { kind = 2; f = 0; }
            else if (loc == tail) { kind = 1; f = 1; } else if (loc == tail + 1) { kind = 2; f = 1; }
            else if (l & 1) kind = 8 + (loc - 2);
            else if (loc < 14) { c = (loc - 2) >> 1; kind = 4 + ((loc - 2) & 1); }
            else kind = loc == 14 ? 6 : 7;
        }
        LAS float* tab = (LAS float*)scr_tab;
        float* PA = (float*)(Q.ws + WS_PA); float* PB = (float*)(Q.ws + WS_PB); float* PC = (float*)(Q.ws + WS_PC); const float* R2 = (const float*)(Q.ws + WS_R2);
        const WPtrs w = wptrs(Q.ws, l);
        const int j = l >> 1;
        if (rep && kind != PROBE_KIND) continue;
        if (st > 2 * lo) { if (st == 2 * lo + 2) grid.sync(); else xcd_barrier(xbar, tid); }
        const float rs = rep ? 0.0f : 1.0f;
        switch (kind) {
        case 0: prologue_phase(Q, gw, ngw, LANE()); break;
        case 1: { if (f) rowscale_prepass(tab, PB, nullptr, T, 2 * FF, 0, tid, bid, G, WGM_FIN);
                  else if (l == 0) rowscale_prepass(tab, nullptr, R2, T, 2 * FF, 0, tid, bid, G, WGM_FIN);
                  else rowscale_prepass(tab, PC, nullptr, T, 2 * FF, 0, tid, bid, G, WGM_FIN, PB);
                  EpiSwiglu E{BIG, tab}; run_gemm(lds, X, f ? w.f2in : w.f1in, T, 2 * FF, D, E, bid, G, tid, WGM_FIN); } break;
        case 2: case 7: case 10: {
            const bf16_t* A = kind == 7 ? H : BIG; const bf16_t* Bt = kind == 2 ? (f ? w.f2out : w.f1out) : (kind == 7 ? w.wo : w.sout);
            const bool lazy = kind == 2 && f == 0 && l > 0, c2 = kind == 2 && f == 1 && l < DEPTH - 1;
            if (lazy) rowscale_prepass(tab, PC, nullptr, T, D, 0, tid, bid, G, WGM_RES, nullptr, 1);
            EpiResid E{X, (kind == 2 ? 0.5f : 1.0f) * rs, kind == 2 ? (f ? (c2 ? PC : nullptr) : PA) : PB, tab, lazy ? Q.in[20] + (l - 1) * D : nullptr, c2 ? PB : nullptr, c2 ? Q.in[20] + l * D : nullptr}; run_gemm(lds, A, Bt, T, D, kind == 2 ? FF : D, E, bid, G, tid, WGM_RES, kind == 2 ? 1 : 0); } break;
        case 4: { rowscale_prepass(tab, PA, nullptr, CH, QKVW, c * CH, tid, bid, G, WGM_QKV);
                  EpiQKV E{BIG, c * CH, Q.in[7] + j * 64, Q.in[8] + j * 64, (const float*)(Q.ws + WS_ROPE), tab};
                  run_gemm(lds, X + (size_t)c * CH * D, w.qkv, CH, QKVW, D, E, bid, G, tid, WGM_QKV);
                  const int nlight = G - (CH / 256) * (QKVW / 256) % G;
                  if (c > 0 && bid >= G - nlight) combine_phase(Q, c - 1, (bid - (G - nlight)) * NTHR + tid, nlight * NTHR); } break;
#ifdef ATTN_OLD
        case 5: attn_phase(Q, lds, c, gw, ngw, wave, LANE(), rep * PROBE_VAR); break;
#else
        case 5: attn_phase_coop(Q, lds, c, bid, G, tid, wave, LANE(), rep * PROBE_VAR); break;
#endif
        case 6: combine_phase(Q, NCH - 1, gt, ngt); break;
        case 8: { rowscale_prepass(tab, PA, nullptr, T, 2 * D, 0, tid, bid, G, WGM_SIN);
                  EpiSguIn E{BIG, (bf16_t*)(Q.ws + WS_BIG + BIG_V), Q.in[11] + j * 2 * D, (float*)(Q.ws + WS_BIG + BIG_ST), tab}; run_gemm(lds, X, w.sin, T, 2 * D, D, E, bid, G, tid, WGM_SIN); } break;
        case 9: spatial_phase(Q, lds, l, tid, wave, LANE(), bid, G); break;
        default: norm_phase<2>(Q, Q.in[20] + l * D, true, gw, ngw, LANE()); break;
        }
#ifdef PROBE_SYNC
        xcd_barrier(xbar, tid);
#endif
    }
}

extern "C" void kernel_launch(void* const* d_in, const int* in_sizes, int n_in, void* d_out, int out_size, void* d_ws, size_t ws_size, hipStream_t stream) {
    static int grid = 0;
    if (grid == 0) {
        if (n_in != 21 || out_size != T * D || ws_size < WS_END) { fprintf(stderr, "kernel_launch: unexpected shapes (n_in %d out %d ws %zu need %zu)\n", n_in, out_size, ws_size, (size_t)WS_END); grid = -1; return; }
        int dev = 0, cus = 0, per_cu = 0;
        hipGetDevice(&dev); hipDeviceGetAttribute(&cus, hipDeviceAttributeMultiprocessorCount, dev);
        hipOccupancyMaxActiveBlocksPerMultiprocessor(&per_cu, (const void*)mega_fwd, NTHR, 0);
        if (per_cu < 1) { fprintf(stderr, "kernel_launch: occupancy query says %d blocks per CU\n", per_cu); per_cu = 1; }
        (void)hipGetLastError();
        grid = cus;
    }
    if (grid < 0) return;
    Params p{};
    for (int i = 0; i < 21; ++i) p.in[i] = (const float*)d_in[i];
    p.out = (float*)d_out; p.ws = (unsigned char*)d_ws;
#if PER_PHASE_LAUNCH
    for (int ph = 0; ph < N_PHASES; ++ph) { p.ph_lo = ph; p.ph_hi = ph + 1; hipLaunchKernelGGL(mega_fwd, dim3(grid), dim3(NTHR), 0, stream, p); }
#else
    p.ph_lo = 0; p.ph_hi = N_PHASES;
    if (hipMemsetAsync(d_ws, 0, 16384, stream) != hipSuccess) { fprintf(stderr, "kernel_launch: memset of the barrier words failed\n"); return; }
    void* args[] = {&p};
    hipError_t e = hipLaunchCooperativeKernel((const void*)mega_fwd, dim3(grid), dim3(NTHR), args, 0, stream);
    if (e != hipSuccess) fprintf(stderr, "kernel_launch: cooperative launch failed: %s (grid %d)\n", hipGetErrorString(e), grid);
#endif
}
```

```cpp
#include <hip/hip_runtime.h>
#include <hip/hip_cooperative_groups.h>
#include <cstdio>
#include <cstdint>
namespace cg = cooperative_groups;
namespace pg8 {
#define PG8_LAS __attribute__((address_space(3)))
typedef unsigned short bf16_t;
typedef short bf16x8 __attribute__((ext_vector_type(8)));
typedef float f32x4 __attribute__((ext_vector_type(4)));
typedef unsigned u32x4 __attribute__((ext_vector_type(4)));
constexpr int BM = 256, BK = 64, HALF = 128, HTB = HALF * BK * 2  , STAGE_BYTES = 8 * HTB, NXCD = 8, WGM = 8;

__host__ __device__ __forceinline__ int lds_byte(int r, int c) { const int st = (r >> 4) * 2 + (c >> 5), rr = r & 15, cc = c & 31, ob = rr * 64 + cc * 2; return st * 1024 + (ob ^ (((ob >> 9) & 1) << 5)); }
__host__ __device__ __forceinline__ void stage_rc(int b, int& R, int& C) { const int st = b / 1024, sb = b % 1024, swz = sb ^ (((sb >> 9) & 1) << 5); R = (st >> 1) * 16 + swz / 64; C = (st & 1) * 32 + (swz % 64) / 2; }
__host__ __device__ __forceinline__ int perm32(int rho) { const int n = rho >> 4, i = rho & 15; return 8 * (i >> 2) + 4 * n + (i & 3); }

struct Unit { int pm, pn, idx; };
struct Gemm { const bf16_t* A; const bf16_t* Bt; int M, N, K; };

struct StaticOrder {
    int nM, nN, nwg, G, c, rev, wgm;
    __host__ __device__ void init(int M, int N, int G_, int c_, int rev_ = 0, int wgm_ = WGM) { nM = M / BM; nN = N / BM; nwg = nM * nN; G = G_; c = c_; rev = rev_; wgm = wgm_; }
    __host__ __device__ bool next(int i, Unit& u) const {
        const long L = (long)i * G + c; if (L >= nwg) return false;
        int wgid = (int)L; { const int q = nwg / NXCD, r = nwg % NXCD, xcd = wgid % NXCD, off = wgid / NXCD; wgid = (xcd < r ? xcd * (q + 1) : r * (q + 1) + (xcd - r) * q) + off; }
        const int nig = wgm * nN, gid = wgid / nig, fm = gid * wgm, gsz = (nM - fm) < wgm ? (nM - fm) : wgm;
        u.pm = fm + ((wgid % nig) % gsz); u.pn = (wgid % nig) / gsz; u.idx = i; if (rev) u.pm = nM - 1 - u.pm; return true;
    }
    __device__ __forceinline__ void a_ready(const Unit&) const {}
    __device__ __forceinline__ void done(const Unit&) const {}
};

__device__ __forceinline__ unsigned cvt_pk_bf16(float lo, float hi) { unsigned r; asm volatile("v_cvt_pk_bf16_f32 %0, %1, %2" : "=v"(r) : "v"(lo), "v"(hi)); return r; }
typedef float f32x2 __attribute__((ext_vector_type(2)));
template <class Epi, class Sched, bool ALIGN_EPI = false, bool SP2 = false>
__device__ __forceinline__ void gemm_phase(PG8_LAS unsigned char* lds, const Gemm g, const Sched& S, const Epi& E, int tid_in) {
    int tid = tid_in; asm volatile("" : "+v"(tid)); const int wid = __builtin_amdgcn_readfirstlane(tid >> 6), lane = tid & 63, wr = wid >> 2, wc = wid & 3, fr = lane & 15, fq = lane >> 4;
    const int K = g.K, nt = K / BK;
    unsigned voffA[2], voffB[2];
#pragma unroll
    for (int i = 0; i < 2; ++i) { int R, C; stage_rc(tid * 16 + i * 8192, R, C); const int Rb = Epi::PERM ? ((R & ~31) + perm32(R & 31)) : R;
        voffA[i] = (unsigned)(R * K + C) * 2u; voffB[i] = (unsigned)(Rb * K + C) * 2u; }
    const size_t kstep = (size_t)(BK * 2);
    const size_t hstep = (size_t)HALF * K * 2;
    const size_t tstep = 2 * hstep;
    const unsigned ldsw = (unsigned)wid * 1024u;
    const int aoff = lds_byte(wr * 64 + fr, fq * 8), boff = lds_byte(wc * 32 + fr, fq * 8);
#define PG8_SA(b, h) (((b) * 2 + (h)) * HTB)
#define PG8_SB(b, h) ((4 + (b) * 2 + (h)) * HTB)
#define PG8_STAGE(bufoff, gbase, voff) do { _Pragma("unroll") for (int _i = 0; _i < 2; ++_i) \
        __builtin_amdgcn_global_load_lds((const unsigned*)((const char*)(gbase) + (voff)[_i]), (PG8_LAS unsigned*)(lds + (bufoff) + ldsw + _i * 8192), 16, 0, 0); } while (0)
#define PG8_LDA(dst, b, h) do { _Pragma("unroll") for (int m = 0; m < 4; ++m) _Pragma("unroll") for (int k = 0; k < 2; ++k) dst[m][k] = *(const PG8_LAS bf16x8*)(lds + PG8_SA(b, h) + aoff + m * 2048 + k * 1024); } while (0)
#define PG8_LDB(dst, b, h) do { _Pragma("unroll") for (int n = 0; n < 2; ++n) _Pragma("unroll") for (int k = 0; k < 2; ++k) dst[n][k] = *(const PG8_LAS bf16x8*)(lds + PG8_SB(b, h) + boff + n * 2048 + k * 1024); } while (0)
#define PG8_MMA(ai, bj, At, Bt) do { __builtin_amdgcn_s_setprio(1); _Pragma("unroll") for (int m = 0; m < 4; ++m) _Pragma("unroll") for (int n = 0; n < 2; ++n) _Pragma("unroll") for (int k = 0; k < 2; ++k) \
        acc[ai][bj][m][n] = __builtin_amdgcn_mfma_f32_16x16x32_bf16(Bt[n][k], At[m][k], acc[ai][bj][m][n], 0, 0, 0); __builtin_amdgcn_s_setprio(0); } while (0)
#define PG8_WAIT_V(n) asm volatile("s_waitcnt vmcnt(" #n ")" ::: "memory")
#define PG8_WAIT_L(n) asm volatile("s_waitcnt lgkmcnt(" #n ")" ::: "memory")
#define PG8_BAR __builtin_amdgcn_s_barrier()
#define PG8_SCHED __builtin_amdgcn_sched_barrier(0)
    Unit cur, nxt; int ui = 0;
    if (!S.next(0, cur)) return;
    f32x4 acc[2][2][4][2];
#pragma unroll
    for (int a = 0; a < 2; ++a)
#pragma unroll
        for (int b = 0; b < 2; ++b)
#pragma unroll
            for (int m = 0; m < 4; ++m)
#pragma unroll
                for (int n = 0; n < 2; ++n) acc[a][b][m][n] = (f32x4){0.f, 0.f, 0.f, 0.f};
    bf16x8 At[4][2], B0[2][2], B1[2][2];
    const char* cA = (const char*)g.A + (size_t)cur.pm * tstep; const char* cB = (const char*)g.Bt + (size_t)cur.pn * tstep;
    S.a_ready(cur);
    if constexpr (SP2) {
        PG8_STAGE(PG8_SB(0, 0), cB, voffB); PG8_STAGE(PG8_SB(0, 1), cB + hstep, voffB); PG8_STAGE(PG8_SA(0, 0), cA, voffA); PG8_STAGE(PG8_SA(0, 1), cA + hstep, voffA);
        if (wr == 1) PG8_BAR;
        PG8_WAIT_V(2); PG8_BAR;
        PG8_STAGE(PG8_SB(1, 0), cB + kstep, voffB); PG8_STAGE(PG8_SA(1, 0), cA + kstep, voffA); PG8_STAGE(PG8_SB(1, 1), cB + hstep + kstep, voffB);
        PG8_WAIT_V(6); PG8_BAR;
    } else {
        PG8_STAGE(PG8_SB(0, 0), cB, voffB); PG8_STAGE(PG8_SA(0, 0), cA, voffA); PG8_STAGE(PG8_SB(0, 1), cB + hstep, voffB); PG8_STAGE(PG8_SA(0, 1), cA + hstep, voffA);
        if (wr == 1) PG8_BAR;
        PG8_WAIT_V(4); PG8_BAR;
        PG8_STAGE(PG8_SB(1, 0), cB + kstep, voffB); PG8_STAGE(PG8_SA(1, 0), cA + kstep, voffA); PG8_STAGE(PG8_SB(1, 1), cB + hstep + kstep, voffB);
        PG8_WAIT_V(6); PG8_BAR;
    }
    for (;;) {
        const bool has_next = S.next(ui + 1, nxt);
        const char* nA = has_next ? (const char*)g.A + (size_t)nxt.pm * tstep : cA; const char* nB = has_next ? (const char*)g.Bt + (size_t)nxt.pn * tstep : cB;
        for (int t = 0; t < nt; t += 2) {
            const bool last = (t == nt - 2);
            const char* a1 = cA + (size_t)(t + 1) * kstep;
            const char* a2 = last ? nA : cA + (size_t)(t + 2) * kstep; const char* b2 = last ? nB : cB + (size_t)(t + 2) * kstep;
            const char* a3 = a2 + kstep; const char* b3 = b2 + kstep;
            if (last && has_next) S.a_ready(nxt);
            if constexpr (SP2) {
            PG8_LDB(B0, 0, 0); PG8_LDB(B1, 0, 1); PG8_SCHED; PG8_LDA(At, 0, 0); PG8_STAGE(PG8_SA(1, 1), a1 + hstep, voffA);
            PG8_WAIT_V(8); PG8_WAIT_L(0); PG8_BAR; PG8_MMA(0, 0, At, B0); PG8_MMA(0, 1, At, B1); PG8_BAR; PG8_SCHED;
            PG8_LDA(At, 0, 1); PG8_STAGE(PG8_SB(0, 0), b2, voffB); PG8_STAGE(PG8_SB(0, 1), b2 + hstep, voffB); PG8_STAGE(PG8_SA(0, 0), a2, voffA);
            PG8_WAIT_V(8); PG8_WAIT_L(0); PG8_BAR; PG8_MMA(1, 0, At, B0); PG8_MMA(1, 1, At, B1); PG8_BAR; PG8_SCHED;
            PG8_LDB(B0, 1, 0); PG8_LDB(B1, 1, 1); PG8_SCHED; PG8_LDA(At, 1, 0); PG8_STAGE(PG8_SA(0, 1), a2 + hstep, voffA);
            PG8_WAIT_V(8); PG8_WAIT_L(0); PG8_BAR; PG8_MMA(0, 0, At, B0); PG8_MMA(0, 1, At, B1); PG8_BAR; PG8_SCHED;
            PG8_LDA(At, 1, 1); PG8_STAGE(PG8_SB(1, 0), b3, voffB); PG8_STAGE(PG8_SB(1, 1), b3 + hstep, voffB); PG8_STAGE(PG8_SA(1, 0), a3, voffA);
            PG8_WAIT_V(8); PG8_WAIT_L(0); PG8_BAR; PG8_MMA(1, 0, At, B0); PG8_MMA(1, 1, At, B1); PG8_BAR; PG8_SCHED;
            } else {
            PG8_LDB(B0, 0, 0); PG8_SCHED; PG8_LDA(At, 0, 0); PG8_STAGE(PG8_SA(1, 1), a1 + hstep, voffA);
            PG8_WAIT_L(8); PG8_BAR; PG8_WAIT_L(0); PG8_MMA(0, 0, At, B0); PG8_BAR; PG8_SCHED;
            PG8_LDB(B1, 0, 1); PG8_STAGE(PG8_SB(0, 0), b2, voffB);
            PG8_BAR; PG8_WAIT_L(0); PG8_MMA(0, 1, At, B1); PG8_BAR;
            PG8_LDA(At, 0, 1); PG8_STAGE(PG8_SA(0, 0), a2, voffA);
            PG8_BAR; PG8_WAIT_L(0); PG8_MMA(1, 0, At, B0); PG8_BAR; PG8_SCHED;
            PG8_STAGE(PG8_SB(0, 1), b2 + hstep, voffB);
            PG8_WAIT_V(6); PG8_BAR; PG8_MMA(1, 1, At, B1); PG8_BAR;
            PG8_LDB(B0, 1, 0); PG8_SCHED; PG8_LDA(At, 1, 0); PG8_STAGE(PG8_SA(0, 1), a2 + hstep, voffA);
            PG8_WAIT_L(8); PG8_BAR; PG8_WAIT_L(0); PG8_MMA(0, 0, At, B0); PG8_BAR; PG8_SCHED;
            PG8_LDB(B1, 1, 1); PG8_STAGE(PG8_SB(1, 0), b3, voffB);
            PG8_BAR; PG8_WAIT_L(0); PG8_MMA(0, 1, At, B1); PG8_BAR;
            PG8_LDA(At, 1, 1); PG8_STAGE(PG8_SA(1, 0), a3, voffA);
            PG8_BAR; PG8_WAIT_L(0); PG8_MMA(1, 0, At, B0); PG8_BAR; PG8_SCHED;
            PG8_STAGE(PG8_SB(1, 1), b3 + hstep, voffB);
            PG8_WAIT_V(6); PG8_BAR; PG8_MMA(1, 1, At, B1); PG8_BAR;
            }
        }
        if constexpr (ALIGN_EPI) { if (wr == 0) PG8_BAR; }
        if constexpr (!Epi::AFTER_DRAIN) { E(acc, cur, wr, wc, fr, fq); S.done(cur); }
        if (!has_next) break;
#pragma unroll
        for (int a = 0; a < 2; ++a)
#pragma unroll
            for (int b = 0; b < 2; ++b)
#pragma unroll
                for (int m = 0; m < 4; ++m)
#pragma unroll
                    for (int n = 0; n < 2; ++n) acc[a][b][m][n] = (f32x4){0.f, 0.f, 0.f, 0.f};
        cur = nxt; cA = nA; cB = nB; ++ui;
        if constexpr (ALIGN_EPI) { if (wr == 1) PG8_BAR; }
    }
    PG8_WAIT_V(0);
    if constexpr (!ALIGN_EPI) { if (wr == 0) PG8_BAR; }
    PG8_BAR;
    if constexpr (Epi::AFTER_DRAIN) { E.fused(acc, cur, wr, wc, fr, fq, lds, wid, lane); S.done(cur); }
#undef PG8_SA
#undef PG8_SB
#undef PG8_STAGE
#undef PG8_LDA
#undef PG8_LDB
#undef PG8_MMA
#undef PG8_WAIT_V
#undef PG8_WAIT_L
#undef PG8_BAR
#undef PG8_SCHED
}
}
#define LAS __attribute__((address_space(3)))
#define XB_TMO      128
#define XB_XCNT(j)  (256  + 64 * (j))
#define XB_XSUB(j)  (1280 + 64 * (j))
#define XB_XGEN(j)  (2304 + 64 * (j))
#define XB_TOP      3328
#define XB_TOPGEN   3392
#define XCD_BAR_WORDS 3456
#define XB_SPIN_CAP (1u << 18)

__device__ __forceinline__ unsigned xb_ld(unsigned* p)              { return __hip_atomic_load(p, __ATOMIC_RELAXED, __HIP_MEMORY_SCOPE_AGENT); }
__device__ __forceinline__ unsigned xb_add(unsigned* p, unsigned v) { return __hip_atomic_fetch_add(p, v, __ATOMIC_RELAXED, __HIP_MEMORY_SCOPE_AGENT); }
__device__ __forceinline__ unsigned xb_xcc_id() { return (unsigned)__builtin_amdgcn_s_getreg((3 << 11) | 20) & 0xFu; }
#define XB_SPIN(cond, bar) do { unsigned _sp = 0; while (cond) { __builtin_amdgcn_s_sleep(1); \
    if ((++_sp & 255u) == 0u) { if (xb_ld(&(bar)[XB_TMO])) break; if (_sp > XB_SPIN_CAP) { atomicAdd(&(bar)[XB_TMO], 1u); break; } } } } while (0)

struct XcdBarrier {
    unsigned* bar; unsigned x;
    volatile LAS unsigned* st;
};

__device__ __forceinline__ XcdBarrier xcd_barrier_post(unsigned* bar, volatile LAS unsigned* st) {
    XcdBarrier b; b.bar = bar; b.x = xb_xcc_id(); b.st = st;
    if (threadIdx.x == 0) (void)xb_add(&bar[XB_XCNT(b.x)], 1u);
    return b;
}
__device__ __forceinline__ void xcd_barrier_complete(unsigned* bar, unsigned x, unsigned& nloc, unsigned& nx) {
    const unsigned G = gridDim.x * gridDim.y * gridDim.z;
    unsigned sum, cnt, mine, sp = 0u;
    for (;;) {
        sum = 0u; cnt = 0u; mine = 0u;
#pragma unroll
        for (unsigned j = 0; j < 16; ++j) { const unsigned c = xb_ld(&bar[XB_XCNT(j)]); sum += c; cnt += (c > 0u) ? 1u : 0u; mine = (j == x) ? c : mine; }
        if (sum == G) break;
        __builtin_amdgcn_s_sleep(1);
        if ((++sp & 255u) == 0u) { if (xb_ld(&bar[XB_TMO])) break; if (sp > XB_SPIN_CAP) { atomicAdd(&bar[XB_TMO], 1u); break; } }
    }
    nloc = mine > 0u ? mine : 1u; nx = cnt > 0u ? cnt : 1u;
}

__device__ __forceinline__ void xcd_barrier(const XcdBarrier& b, int tid_in) {
    asm volatile("s_waitcnt vmcnt(0)" ::: "memory");
    __syncthreads();
    if (tid_in == 0) {
        unsigned* bar = b.bar;
        __builtin_amdgcn_s_waitcnt(0);
        unsigned nloc = b.st[0], nx = b.st[1];
        if (nloc == 0u) { xcd_barrier_complete(bar, b.x, nloc, nx); b.st[0] = nloc; b.st[1] = nx; }
        const unsigned old = xb_add(&bar[XB_XSUB(b.x)], 1u);
        const unsigned gen = old / nloc;
        if (old + 1u == (gen + 1u) * nloc) {
            __builtin_amdgcn_fence(__ATOMIC_RELEASE, "agent");
            asm volatile("s_waitcnt vmcnt(0)" ::: "memory");
            const unsigned og = xb_add(&bar[XB_TOP], 1u);
            const unsigned tg = og / nx;
            if (og + 1u == (tg + 1u) * nx) xb_add(&bar[XB_TOPGEN], 1u);
            else XB_SPIN(xb_ld(&bar[XB_TOPGEN]) == tg, bar);
            __builtin_amdgcn_fence(__ATOMIC_ACQUIRE, "agent");
            xb_add(&bar[XB_XGEN(b.x)], 1u);
            asm volatile("s_waitcnt vmcnt(0)" ::: "memory");
        } else {
            XB_SPIN(xb_ld(&bar[XB_XGEN(b.x)]) == gen, bar);
            __builtin_amdgcn_fence(__ATOMIC_ACQUIRE, "agent");
            asm volatile("s_waitcnt vmcnt(0)" ::: "memory");
        }
    }
    __syncthreads();
}


using pg8::bf16_t; using pg8::bf16x8; using pg8::f32x4; using pg8::u32x4;
typedef float f32x16 __attribute__((ext_vector_type(16)));
typedef short s16x4 __attribute__((ext_vector_type(4)));
typedef unsigned u32x2 __attribute__((ext_vector_type(2)));
typedef float f32x2_t __attribute__((ext_vector_type(2))); typedef __bf16 bf16x2_t __attribute__((ext_vector_type(2)));
#define LAS __attribute__((address_space(3)))
#define MFMA32(a, b, c) __builtin_amdgcn_mfma_f32_32x32x16_bf16((a), (b), (c), 0, 0, 0)

constexpr int D = 1024, T = 49152, TP = 16384, FF = 2816, DEPTH = 4, QKVW = 9216;
constexpr int CH = 8192, NCH = T / CH;
constexpr float EPS = 1e-6f, LOG2E = 1.4426950408889634f;
constexpr int NWAVES = 8, NTHR = 512;

constexpr size_t MiB = 1u << 20;
constexpr size_t WS_ROPE = 1 * MiB;
constexpr size_t WS_STATS = 3 * MiB;
constexpr size_t WS_LSE = 4 * MiB;
constexpr size_t WS_W = 6 * MiB;
constexpr size_t E_FIN = (size_t)2 * FF * D, E_FOUT = (size_t)FF * D;
constexpr size_t E_LAYER = 2 * (E_FIN + E_FOUT);
constexpr size_t E_QKV = (size_t)QKVW * D, E_WO = (size_t)D * D, E_ATT = E_QKV + E_WO;
constexpr size_t E_SIN = (size_t)2 * D * D, E_SOUT = (size_t)D * D, E_WS = 8 * 128 * 128, E_SGU = E_SIN + E_SOUT + E_WS;
constexpr size_t E_WTOT = DEPTH * E_LAYER + 2 * E_ATT + 2 * E_SGU;
constexpr size_t WS_H = WS_W + ((E_WTOT * 2 + MiB - 1) / MiB) * MiB;
constexpr size_t WS_BIG = WS_H + (size_t)T * D * 2;
constexpr size_t WS_PA = WS_BIG + (size_t)T * FF * 2;
constexpr size_t WS_PB = WS_PA + (size_t)T * 16 * 4;
constexpr size_t WS_PC = WS_PB + (size_t)T * 16 * 4;
constexpr size_t WS_END = WS_PC + (size_t)T * 16 * 4;
constexpr size_t WS_W1 = 3 * MiB + 256 * 1024;
constexpr size_t WS_R2 = 3 * MiB;
static_assert(WS_END <= (size_t)588358656, "d_ws is only guaranteed to hold the inputs' bytes");
constexpr size_t BIG_OG = (size_t)CH * QKVW * 2;
constexpr size_t BIG_V = (size_t)T * D * 2;
constexpr size_t BIG_ST = 2 * BIG_V;
static_assert(BIG_OG + (size_t)3 * CH * D * 2 <= (size_t)T * FF * 2 && BIG_ST + (size_t)T * 32 * 4 <= (size_t)T * FF * 2, "BIG overlays");

struct Params {
    const float* in[21];
    float* out; unsigned char* ws;
    int ph_lo, ph_hi;
};

__device__ __forceinline__ unsigned cvtpk(float lo, float hi) { f32x2_t v = {lo, hi}; bf16x2_t b = __builtin_convertvector(v, bf16x2_t); return __builtin_bit_cast(unsigned, b); }
__device__ __forceinline__ float bflo(unsigned u) { return __builtin_bit_cast(float, u << 16); }
__device__ __forceinline__ float bfhi(unsigned u) { return __builtin_bit_cast(float, u & 0xffff0000u); }
__device__ __forceinline__ float wave_sum(float v) {
#pragma unroll
    for (int o = 32; o >= 1; o >>= 1) v += __shfl_xor(v, o);
    return v;
}

struct EpiSwiglu {
    static constexpr bool PERM = true, AFTER_DRAIN = false;
    bf16_t* Hd; const LAS float* scr;
    __device__ __forceinline__ void operator()(const f32x4 (&acc)[2][2][4][2], const pg8::Unit& u, int wr, int wc, int fr, int fq) const {
        const int row0 = u.pm * 256 + wr * 64 + fr, col0 = u.pn * 128 + wc * 32 + 8 * fq;
#pragma unroll
        for (int ai = 0; ai < 2; ++ai)
#pragma unroll
            for (int m = 0; m < 4; ++m) {
                bf16_t* p = Hd + (size_t)(row0 + ai * 128 + m * 16) * FF + col0;
                const float rsc = scr[u.idx * 256 + wr * 64 + fr + ai * 128 + m * 16];
                const float nrl = -rsc * LOG2E, ir2 = __builtin_amdgcn_rcpf(rsc * rsc);
                float h[8];
#pragma unroll
                for (int n = 0; n < 2; ++n)
#pragma unroll
                    for (int j = 0; j < 4; ++j) { const float ag = acc[ai][0][m][n][j], au = acc[ai][1][m][n][j];
                        const float e = __builtin_amdgcn_exp2f(ag * nrl);
                        h[n * 4 + j] = (ag * au) * __builtin_amdgcn_rcpf(__builtin_fmaf(e, ir2, ir2)); }
                u32x4 w; w.x = pg8::cvt_pk_bf16(h[0], h[1]); w.y = pg8::cvt_pk_bf16(h[2], h[3]); w.z = pg8::cvt_pk_bf16(h[4], h[5]); w.w = pg8::cvt_pk_bf16(h[6], h[7]);
                *(u32x4*)p = w;
            }
    }
};
struct EpiResid {
    static constexpr bool PERM = true, AFTER_DRAIN = false;
    bf16_t* X; float scale; float* part; const LAS float* tabin; const float* gin; float* part2; const float* gout;
    __device__ __forceinline__ void operator()(const f32x4 (&acc)[2][2][4][2], const pg8::Unit& u, int wr, int wc, int fr, int fq) const {
        const int row0 = u.pm * 256 + wr * 64 + fr, col0 = u.pn * 256 + wc * 32 + 8 * fq;
        const float* gsel = gin ? gin : gout;
        f32x4 gv[2][2];
#pragma unroll
        for (int bj = 0; bj < 2; ++bj)
#pragma unroll
            for (int n = 0; n < 2; ++n) gv[bj][n] = gsel ? *(const f32x4*)(gsel + col0 + bj * 128 + 4 * n) : (f32x4){1.f, 1.f, 1.f, 1.f};
#pragma unroll
        for (int am = 0; am < 4; ++am) {
            const int ai = am >> 1, mb = (am & 1) * 2;
            u32x4 xr[2][2]; float rin[2];
#pragma unroll
            for (int mm = 0; mm < 2; ++mm) {
                rin[mm] = gin ? tabin[u.idx * 256 + wr * 64 + fr + ai * 128 + (mb + mm) * 16] : 1.0f;
#pragma unroll
                for (int bj = 0; bj < 2; ++bj) xr[mm][bj] = *(const u32x4*)(X + (size_t)(row0 + ai * 128 + (mb + mm) * 16) * D + col0 + bj * 128);
            }
#pragma unroll
            for (int mm = 0; mm < 2; ++mm) {
                float ss = 0.f, ss2 = 0.f;
#pragma unroll
                for (int bj = 0; bj < 2; ++bj) {
                    const f32x4 a0 = acc[ai][bj][mb + mm][0], a1 = acc[ai][bj][mb + mm][1]; const u32x4 x = xr[mm][bj]; u32x4 w;
                    f32x4 x0 = {bflo(x.x), bfhi(x.x), bflo(x.y), bfhi(x.y)}, x1 = {bflo(x.z), bfhi(x.z), bflo(x.w), bfhi(x.w)};
                    if (gin) { x0 = x0 * rin[mm] * gv[bj][0]; x1 = x1 * rin[mm] * gv[bj][1]; }
                    const f32x4 y0 = x0 + a0 * scale, y1 = x1 + a1 * scale;
                    ss += ((y0[0] * y0[0] + y0[1] * y0[1]) + (y0[2] * y0[2] + y0[3] * y0[3])) + ((y1[0] * y1[0] + y1[1] * y1[1]) + (y1[2] * y1[2] + y1[3] * y1[3]));
                    if (part2) { const f32x4 z0 = y0 * gv[bj][0], z1 = y1 * gv[bj][1];
                        ss2 += ((z0[0] * z0[0] + z0[1] * z0[1]) + (z0[2] * z0[2] + z0[3] * z0[3])) + ((z1[0] * z1[0] + z1[1] * z1[1]) + (z1[2] * z1[2] + z1[3] * z1[3])); }
                    w.x = pg8::cvt_pk_bf16(y0[0], y0[1]); w.y = pg8::cvt_pk_bf16(y0[2], y0[3]); w.z = pg8::cvt_pk_bf16(y1[0], y1[1]); w.w = pg8::cvt_pk_bf16(y1[2], y1[3]);
                    *(u32x4*)(X + (size_t)(row0 + ai * 128 + (mb + mm) * 16) * D + col0 + bj * 128) = w;
                }
                if (part) { ss += __shfl_xor(ss, 16); ss += __shfl_xor(ss, 32); if (fq == 0) part[(size_t)(row0 + ai * 128 + (mb + mm) * 16) * 16 + u.pn * 4 + wc] = ss; }
                if (part2) { ss2 += __shfl_xor(ss2, 16); ss2 += __shfl_xor(ss2, 32); if (fq == 0) part2[(size_t)(row0 + ai * 128 + (mb + mm) * 16) * 16 + u.pn * 4 + wc] = ss2; }
            }
            asm volatile("" ::: "memory");
        }
    }
};
struct EpiQKV {
    static constexpr bool PERM = true, AFTER_DRAIN = false;
    bf16_t* QKV; int row_base; const float* qg; const float* kg; const float* rope; const LAS float* scr;
    __device__ __forceinline__ void operator()(const f32x4 (&acc)[2][2][4][2], const pg8::Unit& u, int wr, int wc, int fr, int fq) const {
        const int which = u.pn / 12;
        const int lrow0 = u.pm * 256 + wr * 64 + fr, dcol = u.pn * 256 + wc * 64 + 8 * fq;
        if (which == 2) {
#pragma unroll
            for (int ai = 0; ai < 2; ++ai)
#pragma unroll
                for (int m = 0; m < 4; ++m) {
                    bf16_t* p = QKV + (size_t)(lrow0 + ai * 128 + m * 16) * QKVW + dcol;
                    const float rsc = scr[u.idx * 256 + wr * 64 + fr + ai * 128 + m * 16];
#pragma unroll
                    for (int bj = 0; bj < 2; ++bj) { const f32x4 a = acc[ai][bj][m][0] * rsc, b = acc[ai][bj][m][1] * rsc;
                        u32x4 w; w.x = pg8::cvt_pk_bf16(a[0], a[1]); w.y = pg8::cvt_pk_bf16(a[2], a[3]); w.z = pg8::cvt_pk_bf16(b[0], b[1]); w.w = pg8::cvt_pk_bf16(b[2], b[3]);
                        *(u32x4*)(p + 32 * bj) = w; }
                }
            return;
        }
        const float* gp = which == 0 ? qg : kg; const float sc = which == 0 ? 0.125f * LOG2E : 1.0f;
#pragma unroll
        for (int ap = 0; ap < 4; ++ap) {
            const int ai = ap >> 1, mb = (ap & 1) * 2;
            f32x4 cs[2][4];
            float g1[8], g2[8];
            { const float* gpl = gp; asm volatile("" : "+v"(gpl));
#pragma unroll
              for (int i = 0; i < 8; ++i) { g1[i] = gpl[8 * fq + i] * sc; g2[i] = gpl[32 + 8 * fq + i] * sc; } }
#pragma unroll
            for (int mm = 0; mm < 2; ++mm) {
                const int grow = row_base + lrow0 + ai * 128 + (mb + mm) * 16, pos = grow < TP ? (grow & 8191) : (grow & 2047);
                const f32x4* rp = (const f32x4*)(rope + ((size_t)pos * 32 + 8 * fq) * 2);
#pragma unroll
                for (int i2 = 0; i2 < 4; ++i2) cs[mm][i2] = rp[i2];
            }
#pragma unroll
            for (int mm = 0; mm < 2; ++mm) {
                const int m = mb + mm, lrow = lrow0 + ai * 128 + m * 16;
                float a[8], b[8];
#pragma unroll
                for (int n = 0; n < 2; ++n)
#pragma unroll
                    for (int j = 0; j < 4; ++j) { a[n * 4 + j] = acc[ai][0][m][n][j]; b[n * 4 + j] = acc[ai][1][m][n][j]; }
                float ss = 0.f;
#pragma unroll
                for (int i = 0; i < 8; ++i) ss += a[i] * a[i] + b[i] * b[i];
                ss += __shfl_xor(ss, 16); ss += __shfl_xor(ss, 32);
                const float rsc = scr[u.idx * 256 + wr * 64 + fr + ai * 128 + m * 16];
                const float rinv = rsc * __builtin_amdgcn_rsqf(rsc * rsc * ss * (1.0f / 64.0f) + EPS);
                float o1[8], o2[8];
#pragma unroll
                for (int i2 = 0; i2 < 4; ++i2) { const f32x4 c4 = cs[mm][i2];
                    { const int i = 2 * i2; const float t1 = a[i] * rinv * g1[i], t2 = b[i] * rinv * g2[i]; o1[i] = t1 * c4[0] - t2 * c4[1]; o2[i] = t2 * c4[0] + t1 * c4[1]; }
                    { const int i = 2 * i2 + 1; const float t1 = a[i] * rinv * g1[i], t2 = b[i] * rinv * g2[i]; o1[i] = t1 * c4[2] - t2 * c4[3]; o2[i] = t2 * c4[2] + t1 * c4[3]; } }
                bf16_t* p = QKV + (size_t)lrow * QKVW + dcol;
                u32x4 w; w.x = pg8::cvt_pk_bf16(o1[0], o1[1]); w.y = pg8::cvt_pk_bf16(o1[2], o1[3]); w.z = pg8::cvt_pk_bf16(o1[4], o1[5]); w.w = pg8::cvt_pk_bf16(o1[6], o1[7]);
                *(u32x4*)p = w;
                w.x = pg8::cvt_pk_bf16(o2[0], o2[1]); w.y = pg8::cvt_pk_bf16(o2[2], o2[3]); w.z = pg8::cvt_pk_bf16(o2[4], o2[5]); w.w = pg8::cvt_pk_bf16(o2[6], o2[7]);
                *(u32x4*)(p + 32) = w;
            }
        }
    }
};
struct EpiSguIn {
    static constexpr bool PERM = true, AFTER_DRAIN = false;
    bf16_t* U; bf16_t* V; const float* bias; float* stats; const LAS float* scr;
    __device__ __forceinline__ void operator()(const f32x4 (&acc)[2][2][4][2], const pg8::Unit& u, int wr, int wc, int fr, int fq) const {
        const bool isv = u.pn >= 4;
        bf16_t* O = isv ? V : U;
        const int row0 = u.pm * 256 + wr * 64 + fr, dcol = (u.pn & 3) * 256 + wc * 32 + 8 * fq, bcol = u.pn * 256 + wc * 32 + 8 * fq;
        float bv[2][8];
#pragma unroll
        for (int bj = 0; bj < 2; ++bj)
#pragma unroll
            for (int i = 0; i < 8; ++i) bv[bj][i] = bias[bcol + 128 * bj + i];
#pragma unroll
        for (int ai = 0; ai < 2; ++ai)
#pragma unroll
            for (int m = 0; m < 4; ++m) {
                const int row = row0 + ai * 128 + m * 16;
                const float rsc = scr[u.idx * 256 + wr * 64 + fr + ai * 128 + m * 16];
                float s = 0.f, ss = 0.f;
#pragma unroll
                for (int bj = 0; bj < 2; ++bj) {
                    float z[8];
#pragma unroll
                    for (int n = 0; n < 2; ++n)
#pragma unroll
                        for (int j = 0; j < 4; ++j) { const float x = acc[ai][bj][m][n][j] * rsc + bv[bj][n * 4 + j];
                            const float t = x * __builtin_fmaf(x * x, 0.044715f, 1.0f);
                            const float zz = x * __builtin_amdgcn_rcpf(1.0f + __builtin_amdgcn_exp2f(t * (-2.0f * LOG2E * 0.7978845608028654f)));
                            z[n * 4 + j] = zz; s += zz; ss += zz * zz; }
                    u32x4 w; w.x = pg8::cvt_pk_bf16(z[0], z[1]); w.y = pg8::cvt_pk_bf16(z[2], z[3]); w.z = pg8::cvt_pk_bf16(z[4], z[5]); w.w = pg8::cvt_pk_bf16(z[6], z[7]);
                    *(u32x4*)(O + (size_t)row * D + dcol + 128 * bj) = w;
                }
                if (isv) {
                    s += __shfl_xor(s, 16); s += __shfl_xor(s, 32); ss += __shfl_xor(ss, 16); ss += __shfl_xor(ss, 32);
                    if (fq == 0) { f32x2_t st = {s, ss}; *(f32x2_t*)(stats + ((size_t)row * 16 + (u.pn - 4) * 4 + wc) * 2) = st; }
                }
            }
    }
};

template <int MODE>
__device__ __forceinline__ void norm_phase(const Params& P, const float* g, bool last, int gw, int ngw, int lane) {
    bf16_t* X = (bf16_t*)(P.ws + WS_H); float* R2 = (float*)(P.ws + WS_R2);
    for (int row0 = gw; row0 < T; row0 += 2 * ngw) {
        f32x4 v[2][4]; float s[2];
#pragma unroll
        for (int k = 0; k < 2; ++k) { const int row = row0 + k * ngw;
            if (MODE == 0) { const float* src = row < TP ? P.in[0] + (size_t)row * D : P.in[1] + (size_t)(row - TP) * D;
#pragma unroll
                for (int j = 0; j < 4; ++j) v[k][j] = ((const f32x4*)src)[lane + 64 * j];
            } else {
#pragma unroll
                for (int j = 0; j < 4; ++j) { const u32x2 w = ((const u32x2*)(X + (size_t)row * D))[lane + 64 * j]; v[k][j] = (f32x4){bflo(w.x), bfhi(w.x), bflo(w.y), bfhi(w.y)}; }
            } }
#pragma unroll
        for (int k = 0; k < 2; ++k) { s[k] = 0.f;
#pragma unroll
            for (int j = 0; j < 4; ++j) s[k] += (v[k][j][0] * v[k][j][0] + v[k][j][1] * v[k][j][1]) + (v[k][j][2] * v[k][j][2] + v[k][j][3] * v[k][j][3]); }
#pragma unroll
        for (int k = 0; k < 2; ++k) { const int row = row0 + k * ngw;
            float r = __builtin_amdgcn_rsqf(wave_sum(s[k]) * (1.0f / D) + EPS);
            if (MODE == 0) {
#pragma unroll
                for (int j = 0; j < 4; ++j) { u32x2 w; w.x = cvtpk(v[k][j][0], v[k][j][1]); w.y = cvtpk(v[k][j][2], v[k][j][3]); ((u32x2*)(X + (size_t)row * D))[lane + 64 * j] = w; }
            }
            if (MODE == 2) {
                float s2 = 0.f;
#pragma unroll
                for (int j = 0; j < 4; ++j) { const f32x4 gg = ((const f32x4*)g)[lane + 64 * j]; v[k][j] = v[k][j] * r * gg;
                    s2 += (v[k][j][0] * v[k][j][0] + v[k][j][1] * v[k][j][1]) + (v[k][j][2] * v[k][j][2] + v[k][j][3] * v[k][j][3]); }
                if (last) {
#pragma unroll
                    for (int j = 0; j < 4; ++j) ((f32x4*)((float*)P.out + (size_t)row * D))[lane + 64 * j] = v[k][j];
                    continue;
                }
#pragma unroll
                for (int j = 0; j < 4; ++j) { u32x2 w; w.x = cvtpk(v[k][j][0], v[k][j][1]); w.y = cvtpk(v[k][j][2], v[k][j][3]); ((u32x2*)(X + (size_t)row * D))[lane + 64 * j] = w; }
                r = __builtin_amdgcn_rsqf(wave_sum(s2) * (1.0f / D) + EPS);
            }
            if (lane == 0) R2[row] = r;
        }
    }
}

__device__ __forceinline__ void tconv(const float* W, int K, int N, bf16_t* Wt, const float* gain, int mode, int gw, int ngw, int lane, const float* gain2 = nullptr) {
    const int nbk = N / 32, items = nbk * (K / 64);
    const int kk = lane >> 3, nq = lane & 7;
    for (int it = gw; it < items; it += ngw) {
        const int nb = it % nbk, kb = it / nbk;
        const int n = nb * 32 + nq * 4, k0 = kb * 64 + kk * 8;
        int sc = n;
        if (mode == 1) { const int cc = n & 255; sc = (cc >> 7) * FF + (n >> 8) * 128 + (cc & 127); }
        else if (mode == 2) { const int cc = n & 255; sc = (n & ~255) + ((cc >> 5) & 3) * 64 + (((cc >> 7) << 5) | (cc & 31)); }
        f32x4 v[8];
#pragma unroll
        for (int i = 0; i < 8; ++i) v[i] = *(const f32x4*)(W + (size_t)(k0 + i) * N + sc);
        if (gain) {
            const f32x4 g0 = *(const f32x4*)(gain + k0), g1 = *(const f32x4*)(gain + k0 + 4);
#pragma unroll
            for (int i = 0; i < 4; ++i) { v[i] = v[i] * g0[i]; v[4 + i] = v[4 + i] * g1[i]; }
        }
        if (gain2) {
            const f32x4 g0 = *(const f32x4*)(gain2 + k0), g1 = *(const f32x4*)(gain2 + k0 + 4);
#pragma unroll
            for (int i = 0; i < 4; ++i) { v[i] = v[i] * g0[i]; v[4 + i] = v[4 + i] * g1[i]; }
        }
#pragma unroll
        for (int j = 0; j < 4; ++j) {
            u32x4 w; w.x = cvtpk(v[0][j], v[1][j]); w.y = cvtpk(v[2][j], v[3][j]); w.z = cvtpk(v[4][j], v[5][j]); w.w = cvtpk(v[6][j], v[7][j]);
            *(u32x4*)(Wt + (size_t)(n + j) * K + k0) = w;
        }
    }
}

struct WPtrs { bf16_t *f1in, *f1out, *f2in, *f2out, *qkv, *wo, *sin, *sout, *wsp; };
__device__ __forceinline__ WPtrs wptrs(unsigned char* ws, int layer) {
    bf16_t* w = (bf16_t*)(ws + WS_W); WPtrs r;
    bf16_t* l = w + (size_t)layer * E_LAYER; r.f1in = l; r.f1out = l + E_FIN; r.f2in = l + E_FIN + E_FOUT; r.f2out = l + 2 * E_FIN + E_FOUT;
    bf16_t* a = w + DEPTH * E_LAYER + (size_t)(layer >> 1) * E_ATT; r.qkv = a; r.wo = a + E_QKV;
    bf16_t* s = w + DEPTH * E_LAYER + 2 * E_ATT + (size_t)(layer >> 1) * E_SGU; r.sin = s; r.sout = s + E_SIN; r.wsp = s + E_SIN + E_SOUT;
    return r;
}

__device__ __forceinline__ void prologue_phase(const Params& P, int gw, int ngw, int lane) {
    const int gt = gw * 64 + lane, ngt = ngw * 64;
    { float* rope = (float*)(P.ws + WS_ROPE);
      for (int i = gt; i < 8192 * 32; i += ngt) { const int pos = i >> 5, f = i & 31; const float inv = powf(10000.0f, -(float)f / 32.0f); const float ang = (float)pos * inv;
          rope[2 * i] = cosf(ang); rope[2 * i + 1] = sinf(ang); } }
    { float* W1 = (float*)(P.ws + WS_W1);
      for (int i = gt; i < 2 * 1024; i += ngt) { const float* s = P.in[14] + (size_t)i * 128; float a = 0.f;
          for (int q2 = 0; q2 < 64; ++q2) { const unsigned w = cvtpk(s[2 * q2], s[2 * q2 + 1]); a += bflo(w) + bfhi(w); }
          W1[i] = a; } }
    for (int l = 0; l < DEPTH; ++l) {
        const WPtrs w = wptrs(P.ws, l);
        tconv(P.in[3] + (size_t)l * D * 2 * FF, D, 2 * FF, w.f1in, P.in[2] + l * D, 1, gw, ngw, lane, l > 0 ? P.in[20] + (l - 1) * D : nullptr);
        tconv(P.in[4] + (size_t)l * FF * D, FF, D, w.f1out, nullptr, 0, gw, ngw, lane);
        tconv(P.in[18] + (size_t)l * D * 2 * FF, D, 2 * FF, w.f2in, P.in[17] + l * D, 1, gw, ngw, lane);
        tconv(P.in[19] + (size_t)l * FF * D, FF, D, w.f2out, nullptr, 0, gw, ngw, lane);
        const int j = l >> 1;
        if ((l & 1) == 0) {
            tconv(P.in[6] + (size_t)j * D * QKVW, D, QKVW, w.qkv, P.in[5] + l * D, 2, gw, ngw, lane);
            tconv(P.in[9] + (size_t)j * D * D, D, D, w.wo, nullptr, 0, gw, ngw, lane);
        } else {
            tconv(P.in[10] + (size_t)j * D * 2 * D, D, 2 * D, w.sin, P.in[5] + l * D, 0, gw, ngw, lane);
            tconv(P.in[16] + (size_t)j * D * D, D, D, w.sout, nullptr, 0, gw, ngw, lane);
            const float* s = P.in[14] + (size_t)j * E_WS;
            for (int i = gt; i < (int)E_WS / 2; i += ngt) ((unsigned*)w.wsp)[i] = cvtpk(s[2 * i], s[2 * i + 1]);
        }
    }
    norm_phase<0>(P, nullptr, false, gw, ngw, lane);
}

__device__ __forceinline__ void attn_unit(unsigned lbase, LAS unsigned char* vl, const bf16_t* qkv, bf16_t* og, float* lse, int seq_row0, int d, int r, int L, int m0, int g, int h, int lane, int variant) {
    const int qi = lane & 31, hi = lane >> 5;
    const int mq = m0 + qi;
    const size_t qrow = (size_t)(seq_row0 + mq * d + r);
    bf16x8 qf[4];
    { const bf16_t* qp = qkv + qrow * QKVW + g * 1024 + h * 64 + 8 * hi;
#pragma unroll
      for (int ks = 0; ks < 4; ++ks) qf[ks] = *(const bf16x8*)(qp + 16 * ks); }
    const bf16_t* kcol = qkv + 3072 + g * 1024 + h * 64 + 8 * hi;
    bf16x8 kf[5][4];
#pragma unroll
    for (int j = 0; j < 5; ++j) {
        int mk = m0 - 64 + 32 * j + qi; mk = mk < 0 ? 0 : (mk > L - 1 ? L - 1 : mk);
        const bf16_t* kp = kcol + (size_t)(seq_row0 + mk * d + r) * QKVW;
#pragma unroll
        for (int ks = 0; ks < 4; ++ks) kf[j][ks] = *(const bf16x8*)(kp + 16 * ks);
    }
    f32x16 s[5];
#pragma unroll
    for (int j = 0; j < 5; ++j) {
        f32x16 a;
#pragma unroll
        for (int i = 0; i < 16; ++i) a[i] = 0.f;
#pragma unroll
        for (int ks = 0; ks < 4; ++ks) a = MFMA32(kf[j][ks], qf[ks], a);
        s[j] = a;
    }
    if (variant == 3) { float t = 0.f; for (int j = 0; j < 5; ++j) t += s[j][0] + s[j][15]; if (t == 12345.678f) lse[qrow * 16 + h] = t; return; }
    const bf16_t* vcol = qkv + 6144 + g * 1024 + h * 64 + (lane & 7) * 8;
    u32x4 vv[5][4];
#pragma unroll
    for (int j = 0; j < 5; ++j)
#pragma unroll
        for (int i = 0; i < 4; ++i) { int mk = m0 - 64 + 32 * j + (lane >> 3) + 8 * i; mk = mk < 0 ? 0 : (mk > L - 1 ? L - 1 : mk);
            vv[j][i] = *(const u32x4*)(vcol + (size_t)(seq_row0 + mk * d + r) * QKVW); }
    float mx = -INFINITY;
    if (m0 - 64 >= 0 && m0 + 96 <= L) {
#pragma unroll
        for (int rr = 0; rr < 16; ++rr) { const int kin = 8 * (rr >> 2) + 4 * hi + (rr & 3);
            s[0][rr] = kin >= qi ? s[0][rr] : -INFINITY; s[4][rr] = kin <= qi ? s[4][rr] : -INFINITY; }
    } else {
#pragma unroll
        for (int j = 0; j < 5; ++j)
#pragma unroll
            for (int rr = 0; rr < 16; ++rr) {
                const int kin = 8 * (rr >> 2) + 4 * hi + (rr & 3), mk = m0 - 64 + 32 * j + kin, df = mk - mq;
                const bool valid = (mk >= 0) && (mk < L) && (df >= -64) && (df <= 64);
                s[j][rr] = valid ? s[j][rr] : -INFINITY;
            }
    }
#pragma unroll
    for (int j = 0; j < 5; ++j)
#pragma unroll
        for (int rr = 0; rr < 16; ++rr) mx = fmaxf(mx, s[j][rr]);
    mx = fmaxf(mx, __shfl_xor(mx, 32));
    float l = 0.f;
#pragma unroll
    for (int j = 0; j < 5; ++j)
#pragma unroll
        for (int rr = 0; rr < 16; ++rr) { const float p = __builtin_amdgcn_exp2f(s[j][rr] - mx); s[j][rr] = p; l += p; }
    l += __shfl_xor(l, 32);
    if (variant == 2) { if (l == 12345.678f) lse[qrow * 16 + h] = l + mx; return; }
    f32x16 o[2];
#pragma unroll
    for (int i = 0; i < 16; ++i) { o[0][i] = 0.f; o[1][i] = 0.f; }
    const int i16 = lane & 15;
    const unsigned la = lbase + (unsigned)((4 * hi + (i16 >> 2)) * 192 + (16 * ((lane >> 4) & 1) + 4 * (i16 & 3)) * 2);
#pragma unroll
    for (int j = 0; j < 5; ++j) {
#pragma unroll
        for (int i = 0; i < 4; ++i) *(LAS u32x4*)(vl + ((lane >> 3) + 8 * i) * 192 + (lane & 7) * 16) = vv[j][i];
        s16x4 t[8];
#define TRRD(dst, off) asm volatile("ds_read_b64_tr_b16 %0, %1 offset:%2" : "=&v"(dst) : "v"(la), "i"(off) : "memory")
        TRRD(t[0], 0); TRRD(t[1], 8 * 192); TRRD(t[2], 64); TRRD(t[3], 8 * 192 + 64);
        TRRD(t[4], 16 * 192); TRRD(t[5], 24 * 192); TRRD(t[6], 16 * 192 + 64); TRRD(t[7], 24 * 192 + 64);
        asm volatile("s_waitcnt lgkmcnt(0)" : "+v"(t[0]), "+v"(t[1]), "+v"(t[2]), "+v"(t[3]), "+v"(t[4]), "+v"(t[5]), "+v"(t[6]), "+v"(t[7]) :: "memory");
#pragma unroll
        for (int s2 = 0; s2 < 2; ++s2) {
            u32x4 pw; pw.x = cvtpk(s[j][8 * s2 + 0], s[j][8 * s2 + 1]); pw.y = cvtpk(s[j][8 * s2 + 2], s[j][8 * s2 + 3]); pw.z = cvtpk(s[j][8 * s2 + 4], s[j][8 * s2 + 5]); pw.w = cvtpk(s[j][8 * s2 + 6], s[j][8 * s2 + 7]);
            const bf16x8 pb = __builtin_bit_cast(bf16x8, pw);
#pragma unroll
            for (int mt = 0; mt < 2; ++mt) {
                const bf16x8 va = __builtin_shufflevector(t[4 * s2 + 2 * mt], t[4 * s2 + 2 * mt + 1], 0, 1, 2, 3, 4, 5, 6, 7);
                o[mt] = MFMA32(va, pb, o[mt]);
            }
        }
    }
    if (variant == 1) { if (o[0][0] + o[1][5] == 12345.678f) lse[qrow * 16 + h] = l; return; }
    const float inv = 1.0f / l;
#pragma unroll
    for (int mt = 0; mt < 2; ++mt)
#pragma unroll
        for (int g4 = 0; g4 < 4; ++g4) { u32x2 w; w.x = cvtpk(o[mt][4 * g4] * inv, o[mt][4 * g4 + 1] * inv); w.y = cvtpk(o[mt][4 * g4 + 2] * inv, o[mt][4 * g4 + 3] * inv);
            *(LAS u32x2*)(vl + qi * 144 + (32 * mt + 8 * g4 + 4 * hi) * 2) = w; }
#pragma unroll
    for (int i = 0; i < 4; ++i) { const int qq = (lane >> 3) + 8 * i;
        const u32x4 w = *(const LAS u32x4*)(vl + qq * 144 + (lane & 7) * 16);
        *(u32x4*)(og + (size_t)(seq_row0 + (m0 + qq) * d + r) * D + h * 64 + (lane & 7) * 8) = w; }
    if (hi == 0) lse[qrow * 16 + h] = mx + __builtin_amdgcn_logf(l);
}

__device__ __forceinline__ void attn_phase(const Params& P, LAS unsigned char* lds, int chunk, int gw, int ngw, int wave, int lane, int variant) {
    const bf16_t* qkv = (const bf16_t*)(P.ws + WS_BIG);
    bf16_t* og = (bf16_t*)(P.ws + WS_BIG + BIG_OG);
    float* lse = (float*)(P.ws + WS_LSE);
    LAS unsigned char* vl = lds + wave * 6144;
    const unsigned lbase = (unsigned)(size_t)vl;
    const int S = chunk < 2 ? 8192 : 2048;
    for (int u = gw; u < 3 * 16 * (CH / 32); u += ngw) {
        const int g = u / 4096, rem = u % 4096, h = rem / 256, rem2 = rem % 256;
        const int d = g == 0 ? 1 : (g == 1 ? 4 : 16);
        const int bps = S / 32, seq = rem2 / bps, rem3 = rem2 % bps, L = S / d, bpr = L / 32, r = rem3 / bpr, blk = rem3 % bpr;
        attn_unit(lbase, vl, qkv, og + (size_t)g * CH * D, lse + (size_t)g * CH * 16, seq * S, d, r, L, blk * 32, g, h, lane, variant);
    }
}

struct CoopUnit { int seq_row0, d, r, L, m0, g, h, ncls; };
__device__ __forceinline__ CoopUnit coop_decode(int bu, int S) {
    CoopUnit c; c.g = bu / 512; const int rem = bu % 512; c.h = rem / 32; const int sp = rem % 32;
    c.d = c.g == 0 ? 1 : (c.g == 1 ? 4 : 16); c.L = S / c.d;
    const int sps = S / 256, seq = sp / sps, rem2 = sp % sps; c.seq_row0 = seq * S;
    if (c.L >= 256) { const int spc = c.L / 256; c.r = rem2 / spc; c.m0 = 256 * (rem2 % spc); c.ncls = 1; }
    else { c.r = 2 * rem2; c.m0 = 0; c.ncls = 2; }
    return c;
}
__device__ __forceinline__ long coop_piece(const CoopUnit& c, int p) {
    const int slot = p >> 8, row = (p >> 3) & 31, ch = p & 7;
    int kb, cls = 0;
    if (c.ncls == 1) kb = c.m0 - 64 + 32 * slot; else { if (slot >= 8) return -1; cls = slot >> 2; kb = 32 * (slot & 3); }
    if (kb < 0 || kb >= c.L) return -1;
    return (long)(c.seq_row0 + (kb + row) * c.d + c.r + cls) * QKVW + c.g * 1024 + c.h * 64 + ch * 8;
}
__device__ __forceinline__ void coop_qload(const CoopUnit& c, const bf16_t* qkv, int wave, int qi, int hi, bf16x8 (&qf)[4]) {
    const int cls = c.ncls == 2 ? (wave >> 2) : 0, qb = c.ncls == 2 ? (wave & 3) : wave;
    const bf16_t* qp = qkv + (size_t)(c.seq_row0 + (c.m0 + 32 * qb + qi) * c.d + c.r + cls) * QKVW + c.g * 1024 + c.h * 64 + 8 * hi;
#pragma unroll
    for (int ks = 0; ks < 4; ++ks) qf[ks] = *(const bf16x8*)(qp + 16 * ks);
}
constexpr int CO_K = 0, CO_V = 12 * 4608;

__device__ __forceinline__ void attn_phase_coop(const Params& P, LAS unsigned char* lds, int chunk, int bid, int G, int tid, int wave, int lane, int variant) {
    const bf16_t* qkv = (const bf16_t*)(P.ws + WS_BIG);
    bf16_t* ogb = (bf16_t*)(P.ws + WS_BIG + BIG_OG);
    float* lseb = (float*)(P.ws + WS_LSE);
    const int S = chunk < 2 ? 8192 : 2048;
    const int NBU = 3 * 16 * (CH / 256);
    const int qi = lane & 31, hi = lane >> 5, i16 = lane & 15;
    u32x4 pk[6], pv[6]; bf16x8 qn[4];
    int bu = (G % 8 == 0) ? (bid % 8) * (G / 8) + bid / 8 : bid;
    if (bu < NBU) { const CoopUnit c = coop_decode(bu, S); coop_qload(c, qkv, wave, qi, hi, qn);
#pragma unroll
        for (int i = 0; i < 6; ++i) { const long o = coop_piece(c, tid + NTHR * i); pk[i] = (u32x4){0u, 0u, 0u, 0u}; pv[i] = pk[i];
            if (o >= 0) { pk[i] = *(const u32x4*)(qkv + 3072 + o); pv[i] = *(const u32x4*)(qkv + 6144 + o); } } }
    for (; bu < NBU; bu += G) {
        const CoopUnit c = coop_decode(bu, S);
        int t2 = tid; asm volatile("" : "+v"(t2));
#pragma unroll
        for (int i = 0; i < 6; ++i) { const int p = t2 + NTHR * i, slot = p >> 8, row = (p >> 3) & 31, ch = p & 7;
            *(LAS u32x4*)(lds + CO_K + slot * 4608 + row * 144 + ch * 16) = pk[i];
            *(LAS u32x4*)(lds + CO_V + slot * 6144 + row * 192 + ch * 16) = pv[i]; }
        __syncthreads();
        if (bu + G < NBU) { const CoopUnit cn = coop_decode(bu + G, S);
            int t3 = tid; asm volatile("" : "+v"(t3));
#pragma unroll
            for (int i = 0; i < 6; ++i) { const long o = coop_piece(cn, t3 + NTHR * i); pk[i] = (u32x4){0u, 0u, 0u, 0u}; pv[i] = pk[i];
                if (o >= 0) { pk[i] = *(const u32x4*)(qkv + 3072 + o); pv[i] = *(const u32x4*)(qkv + 6144 + o); } } }
        const int cls = c.ncls == 2 ? (wave >> 2) : 0, qb = c.ncls == 2 ? (wave & 3) : wave;
        const int mq = c.m0 + 32 * qb + qi;
        const size_t qrow = (size_t)(c.seq_row0 + mq * c.d + c.r + cls);
        f32x16 s[5]; int slotj[5]; bool vj[5];
#pragma unroll
        for (int j = 0; j < 5; ++j) {
            const int t = qb + j, kb = c.m0 - 64 + 32 * t;
            vj[j] = (kb >= 0) && (kb < c.L); slotj[j] = c.ncls == 2 ? cls * 4 + (t - 2) : t;
            f32x16 a;
#pragma unroll
            for (int i = 0; i < 16; ++i) a[i] = vj[j] ? 0.f : -INFINITY;
            if (vj[j]) {
                const LAS unsigned char* kp = lds + CO_K + slotj[j] * 4608 + qi * 144 + hi * 16;
#pragma unroll
                for (int ks = 0; ks < 4; ++ks) { const bf16x8 kf = *(const LAS bf16x8*)(kp + ks * 32); a = MFMA32(kf, qn[ks], a); }
            }
            s[j] = a;
        }
        if (bu + G < NBU) { const CoopUnit cn = coop_decode(bu + G, S); coop_qload(cn, qkv, wave, qi, hi, qn); }
#pragma unroll
        for (int rr = 0; rr < 16; ++rr) { const int kin = 8 * (rr >> 2) + 4 * hi + (rr & 3);
            s[0][rr] = kin >= qi ? s[0][rr] : -INFINITY; s[4][rr] = kin <= qi ? s[4][rr] : -INFINITY; }
        float mx = -INFINITY;
#pragma unroll
        for (int j = 0; j < 5; ++j)
#pragma unroll
            for (int rr = 0; rr < 16; ++rr) mx = fmaxf(mx, s[j][rr]);
        mx = fmaxf(mx, __shfl_xor(mx, 32));
        float l = 0.f;
#pragma unroll
        for (int j = 0; j < 5; ++j)
#pragma unroll
            for (int rr = 0; rr < 16; ++rr) { const float p = __builtin_amdgcn_exp2f(s[j][rr] - mx); s[j][rr] = p; l += p; }
        l += __shfl_xor(l, 32);
        f32x16 o[2];
#pragma unroll
        for (int i = 0; i < 16; ++i) { o[0][i] = 0.f; o[1][i] = 0.f; }
        const unsigned lav = (unsigned)(size_t)(lds + CO_V) + (unsigned)((4 * hi + (i16 >> 2)) * 192 + (16 * ((lane >> 4) & 1) + 4 * (i16 & 3)) * 2);
        unsigned laj[5];
#pragma unroll
        for (int j = 0; j < 5; ++j) laj[j] = lav + (unsigned)(vj[j] ? slotj[j] : 0) * 6144u;
        s16x4 ta[8], tb[8];
#define TRRDC(dst, LA, off) asm volatile("ds_read_b64_tr_b16 %0, %1 offset:%2" : "=&v"(dst) : "v"(LA), "i"(off) : "memory")
#define TR_ISSUE(T, LA) do { TRRDC(T[0], LA, 0); TRRDC(T[1], LA, 8 * 192); TRRDC(T[2], LA, 64); TRRDC(T[3], LA, 8 * 192 + 64); \
                             TRRDC(T[4], LA, 16 * 192); TRRDC(T[5], LA, 24 * 192); TRRDC(T[6], LA, 16 * 192 + 64); TRRDC(T[7], LA, 24 * 192 + 64); } while (0)
#define TR_WAIT(N, T) asm volatile("s_waitcnt lgkmcnt(" #N ")" : "+v"(T[0]), "+v"(T[1]), "+v"(T[2]), "+v"(T[3]), "+v"(T[4]), "+v"(T[5]), "+v"(T[6]), "+v"(T[7]) :: "memory")
#define PV_TILE(J, T) do { _Pragma("unroll") for (int s2 = 0; s2 < 2; ++s2) { \
            u32x4 pw; pw.x = cvtpk(s[J][8 * s2 + 0], s[J][8 * s2 + 1]); pw.y = cvtpk(s[J][8 * s2 + 2], s[J][8 * s2 + 3]); pw.z = cvtpk(s[J][8 * s2 + 4], s[J][8 * s2 + 5]); pw.w = cvtpk(s[J][8 * s2 + 6], s[J][8 * s2 + 7]); \
            const bf16x8 pb = __builtin_bit_cast(bf16x8, pw); \
            _Pragma("unroll") for (int mt = 0; mt < 2; ++mt) { \
                const bf16x8 va = __builtin_shufflevector(T[4 * s2 + 2 * mt], T[4 * s2 + 2 * mt + 1], 0, 1, 2, 3, 4, 5, 6, 7); \
                o[mt] = MFMA32(va, pb, o[mt]); } } } while (0)
        TR_ISSUE(ta, laj[0]);
        TR_ISSUE(tb, laj[1]); TR_WAIT(8, ta); PV_TILE(0, ta);
        TR_ISSUE(ta, laj[2]); TR_WAIT(8, tb); PV_TILE(1, tb);
        TR_ISSUE(tb, laj[3]); TR_WAIT(8, ta); PV_TILE(2, ta);
        TR_ISSUE(ta, laj[4]); TR_WAIT(8, tb); PV_TILE(3, tb);
        TR_WAIT(0, ta); PV_TILE(4, ta);
        __syncthreads();
        const float inv = 1.0f / l;
        LAS unsigned char* vl = lds + CO_K + wave * 4608;
#pragma unroll
        for (int mt = 0; mt < 2; ++mt)
#pragma unroll
            for (int g4 = 0; g4 < 4; ++g4) { u32x2 w; w.x = cvtpk(o[mt][4 * g4] * inv, o[mt][4 * g4 + 1] * inv); w.y = cvtpk(o[mt][4 * g4 + 2] * inv, o[mt][4 * g4 + 3] * inv);
                *(LAS u32x2*)(vl + qi * 144 + (32 * mt + 8 * g4 + 4 * hi) * 2) = w; }
        bf16_t* og = ogb + (size_t)c.g * CH * D; float* lse = lseb + (size_t)c.g * CH * 16;
#pragma unroll
        for (int i = 0; i < 4; ++i) { const int qq = (lane >> 3) + 8 * i;
            const u32x4 w = *(const LAS u32x4*)(vl + qq * 144 + (lane & 7) * 16);
            *(u32x4*)(og + (size_t)(c.seq_row0 + (c.m0 + 32 * qb + qq) * c.d + c.r + cls) * D + c.h * 64 + (lane & 7) * 8) = w; }
        if (hi == 0) lse[qrow * 16 + c.h] = mx + __builtin_amdgcn_logf(l);
        __syncthreads();
    }
    (void)variant;
}

__device__ __forceinline__ void combine_phase(const Params& P, int chunk, int gt, int ngt) {
    const bf16_t* og = (const bf16_t*)(P.ws + WS_BIG + BIG_OG);
    const float* lse = (const float*)(P.ws + WS_LSE);
    bf16_t* H = (bf16_t*)P.out + (size_t)chunk * CH * D;
    for (int i = gt; i < CH * 128; i += ngt) {
        const int row = i >> 7, c8 = i & 127, h = c8 >> 3;
        const float l0 = lse[(size_t)row * 16 + h], l1 = lse[(size_t)(CH + row) * 16 + h], l2 = lse[(size_t)(2 * CH + row) * 16 + h];
        const float m = fmaxf(l0, fmaxf(l1, l2));
        float w0 = __builtin_amdgcn_exp2f(l0 - m), w1 = __builtin_amdgcn_exp2f(l1 - m), w2 = __builtin_amdgcn_exp2f(l2 - m);
        const float inv = 1.0f / (w0 + w1 + w2); w0 *= inv; w1 *= inv; w2 *= inv;
        const u32x4 a = *(const u32x4*)(og + (size_t)row * D + c8 * 8), b = *(const u32x4*)(og + (size_t)(CH + row) * D + c8 * 8), c = *(const u32x4*)(og + (size_t)(2 * CH + row) * D + c8 * 8);
        u32x4 o;
#pragma unroll
        for (int k = 0; k < 4; ++k) o[k] = cvtpk(w0 * bflo(a[k]) + w1 * bflo(b[k]) + w2 * bflo(c[k]), w0 * bfhi(a[k]) + w1 * bfhi(b[k]) + w2 * bfhi(c[k]));
        *(u32x4*)(H + (size_t)row * D + c8 * 8) = o;
    }
}

__device__ __forceinline__ void spatial_phase(const Params& P, LAS unsigned char* lds, int layer, int tid, int wave, int lane, int bid, int G) {
    const int j = layer >> 1;
    bf16_t* U = (bf16_t*)(P.ws + WS_BIG); const bf16_t* V = (const bf16_t*)(P.ws + WS_BIG + BIG_V);
    const float* stats = (const float*)(P.ws + WS_BIG + BIG_ST);
    const bf16_t* wsp = wptrs(P.ws, layer).wsp;
    const float* bs = P.in[15] + j * 8 * 128; const float* lng = P.in[12] + j * D; const float* lnb = P.in[13] + j * D;
    const unsigned lb = (unsigned)(size_t)lds;
    const int hi = lane >> 5, i16 = lane & 15, pb = (wave & 3) * 32, chh = (wave >> 2) * 64;
    const unsigned la = lb + (unsigned)((8 * hi + (i16 >> 2)) * 320 + (chh + 16 * ((lane >> 4) & 1) + 4 * (i16 & 3)) * 2);
    const float* W1 = (const float*)(P.ws + WS_W1) + j * 1024;
    for (int unit = (G % 8 == 0) ? (bid % 8) * (G / 8) + bid / 8 : bid; unit < (T / 128) * 8; unit += G) {
        const int n = unit >> 3, g = unit & 7;
        const int q = tid >> 2, part = tid & 3; const size_t tok = (size_t)n * 128 + q;
        const f32x4 st0 = *(const f32x4*)(stats + tok * 32 + 8 * part), st1 = *(const f32x4*)(stats + tok * 32 + 8 * part + 4);
        const int c0 = g * 128 + part * 32;
        u32x4 vv[4];
#pragma unroll
        for (int k = 0; k < 4; ++k) vv[k] = *(const u32x4*)(V + tok * D + c0 + 8 * k);
        const bf16_t* ap = wsp + ((size_t)g * 128 + pb + (lane & 31)) * 128 + 8 * hi;
        bf16x8 af[8];
#pragma unroll
        for (int s = 0; s < 8; ++s) af[s] = *(const bf16x8*)(ap + 16 * s);
        unsigned short uu[2][16]; float bsv[16], w1v[16], lgv[2], lbv[2];
#pragma unroll
        for (int rr = 0; rr < 16; ++rr) { const int p = pb + 8 * (rr >> 2) + 4 * hi + (rr & 3); bsv[rr] = bs[g * 128 + p]; w1v[rr] = W1[g * 128 + p]; }
#pragma unroll
        for (int nt = 0; nt < 2; ++nt) { const int c = chh + 32 * nt + (lane & 31); lgv[nt] = lng[g * 128 + c]; lbv[nt] = lnb[g * 128 + c];
#pragma unroll
            for (int rr = 0; rr < 16; ++rr) { const int p = pb + 8 * (rr >> 2) + 4 * hi + (rr & 3); uu[nt][rr] = U[((size_t)n * 128 + p) * D + g * 128 + c]; } }
        { float s1 = (st0[0] + st0[2]) + (st1[0] + st1[2]), s2 = (st0[1] + st0[3]) + (st1[1] + st1[3]);
          s1 += __shfl_xor(s1, 1); s1 += __shfl_xor(s1, 2); s2 += __shfl_xor(s2, 1); s2 += __shfl_xor(s2, 2);
          const float mean = s1 * (1.0f / D), var = s2 * (1.0f / D) - mean * mean, rstd = __builtin_amdgcn_rsqf(fmaxf(var, 0.f) + EPS);
#pragma unroll
          for (int k = 0; k < 4; ++k) { const u32x4 v = vv[k]; u32x4 w;
              w.x = cvtpk((bflo(v.x) - mean) * rstd, (bfhi(v.x) - mean) * rstd); w.y = cvtpk((bflo(v.y) - mean) * rstd, (bfhi(v.y) - mean) * rstd);
              w.z = cvtpk((bflo(v.z) - mean) * rstd, (bfhi(v.z) - mean) * rstd); w.w = cvtpk((bflo(v.w) - mean) * rstd, (bfhi(v.w) - mean) * rstd);
              *(LAS u32x4*)(lds + q * 320 + (part * 32 + 8 * k) * 2) = w; } }
        __syncthreads();
        f32x16 acc[2];
#pragma unroll
        for (int i = 0; i < 16; ++i) { acc[0][i] = 0.f; acc[1][i] = 0.f; }
#pragma unroll
        for (int s = 0; s < 8; ++s) {
            s16x4 t[4];
#define TRRD2(dst, off) asm volatile("ds_read_b64_tr_b16 %0, %1 offset:%2" : "=&v"(dst) : "v"(la), "i"(off) : "memory")
            TRRD2(t[0], s * 16 * 320); TRRD2(t[1], s * 16 * 320 + 4 * 320); TRRD2(t[2], s * 16 * 320 + 64); TRRD2(t[3], s * 16 * 320 + 4 * 320 + 64);
            asm volatile("s_waitcnt lgkmcnt(0)" : "+v"(t[0]), "+v"(t[1]), "+v"(t[2]), "+v"(t[3]) :: "memory");
#pragma unroll
            for (int nt = 0; nt < 2; ++nt) { const bf16x8 b = __builtin_shufflevector(t[2 * nt], t[2 * nt + 1], 0, 1, 2, 3, 4, 5, 6, 7); acc[nt] = MFMA32(af[s], b, acc[nt]); }
        }
#pragma unroll
        for (int nt = 0; nt < 2; ++nt)
#pragma unroll
            for (int rr = 0; rr < 16; ++rr) {
                const int p = pb + 8 * (rr >> 2) + 4 * hi + (rr & 3), c = chh + 32 * nt + (lane & 31);
                const float uv = __builtin_bit_cast(float, (unsigned)uu[nt][rr] << 16) * (lgv[nt] * acc[nt][rr] + (lbv[nt] * w1v[rr] + bsv[rr]));
                U[((size_t)n * 128 + p) * D + g * 128 + c] = (bf16_t)(cvtpk(uv, 0.f) & 0xffffu);
            }
        __syncthreads();
    }
}

#ifndef PER_PHASE_LAUNCH
#define PER_PHASE_LAUNCH 0
#endif
constexpr int N_PHASES = 1 + 2 * (18 + 7) + 1;

__device__ __forceinline__ void rowscale_prepass(LAS float* tab, const float* __restrict__ part, const float* __restrict__ r2, int M, int N, int row_base, int tid, int bid, int G, int wgm, const float* __restrict__ partg = nullptr, int rev = 0) {
    pg8::StaticOrder S; S.init(M, N, G, bid, rev, wgm); pg8::Unit u;
    int nu = 0; while (S.next(nu, u)) ++nu;
    for (int it0 = tid; it0 < nu * 256; it0 += 4 * NTHR) {
        float v[4];
#pragma unroll
        for (int k = 0; k < 4; ++k) { const int it = it0 + k * NTHR; v[k] = 0.f;
            if (it < nu * 256) { S.next(it >> 8, u); const size_t row = (size_t)(row_base + u.pm * 256 + (it & 255));
                if (part) { const f32x4* p = (const f32x4*)(part + row * 16); const f32x4 a = p[0], b = p[1], c = p[2], d = p[3];
                    const float s = ((a[0] + a[1]) + (a[2] + a[3])) + ((b[0] + b[1]) + (b[2] + b[3])) + (((c[0] + c[1]) + (c[2] + c[3])) + ((d[0] + d[1]) + (d[2] + d[3])));
                    v[k] = __builtin_amdgcn_rsqf(s * (1.0f / D) + EPS);
                    if (partg) {
                        const f32x4* pg = (const f32x4*)(partg + row * 16); const f32x4 e = pg[0], f = pg[1], g = pg[2], h = pg[3];
                        const float s2 = ((e[0] + e[1]) + (e[2] + e[3])) + ((f[0] + f[1]) + (f[2] + f[3])) + (((g[0] + g[1]) + (g[2] + g[3])) + ((h[0] + h[1]) + (h[2] + h[3])));
                        v[k] = v[k] * __builtin_amdgcn_rsqf(v[k] * v[k] * s2 * (1.0f / D) + EPS); } }
                else v[k] = r2[row]; } }
#pragma unroll
        for (int k = 0; k < 4; ++k) { const int it = it0 + k * NTHR; if (it < nu * 256) tab[it] = v[k]; }
    }
    __syncthreads();
}
template <class Epi>
__device__ __forceinline__ void run_gemm(LAS unsigned char* lds, const bf16_t* A, const bf16_t* Bt, int M, int N, int K, const Epi& E, int bid, int G, int tid, int wgm, int rev = 0) {
    pg8::Gemm g{A, Bt, M, N, K}; pg8::StaticOrder S; S.init(M, N, G, bid, rev, wgm);
    pg8::gemm_phase<Epi, pg8::StaticOrder, true, true>(lds, g, S, E, tid);
}

__global__ void __launch_bounds__(NTHR, 2) mega_fwd(Params P) {
    __shared__ __attribute__((aligned(16))) unsigned char lds_raw[pg8::STAGE_BYTES];
    LAS unsigned char* lds = (LAS unsigned char*)lds_raw;
    __shared__ float scr_tab[17 * 256];
    __shared__ uint4 xb_words;
    cg::grid_group grid = cg::this_grid();
    const int lo = P.ph_lo, hi = P.ph_hi;
    const int wave_s = __builtin_amdgcn_readfirstlane(threadIdx.x >> 6);
    if (threadIdx.x == 0) xb_words = make_uint4(0u, 0u, 0u, 0u);
    __syncthreads();
    XcdBarrier xbar = xcd_barrier_post((unsigned*)P.ws, (volatile LAS unsigned*)&xb_words);
#ifndef PROBE_KIND
#define PROBE_KIND (-1)
#endif
#ifndef WGM_FIN
#define WGM_FIN 4
#endif
#ifndef WGM_RES
#define WGM_RES 4
#endif
#ifndef WGM_QKV
#define WGM_QKV 4
#endif
#ifndef WGM_SIN
#define WGM_SIN 4
#endif
#ifndef PROBE_VAR
#define PROBE_VAR 0
#endif
#pragma nounroll
    for (int st = 2 * lo; st < 2 * hi; ++st) {
        const int pi = st >> 1, rep = st & 1;
        int wsl = wave_s; asm volatile("" : "+s"(wsl));
        int tid = wsl * 64 + (int)__builtin_amdgcn_mbcnt_hi(~0u, __builtin_amdgcn_mbcnt_lo(~0u, 0u)); asm volatile("" : "+v"(tid));
        int bid = blockIdx.x; asm volatile("" : "+s"(bid));
        int G = gridDim.x; asm volatile("" : "+s"(G));
        Params Q = P;
        { size_t zoff = 0; asm volatile("" : "+s"(zoff));
          Q.ws = P.ws + zoff; Q.out = (float*)((unsigned char*)P.out + zoff); }
#define LANE() ({ int _l = tid & 63; asm volatile("" : "+v"(_l)); _l; })
        const int wave = wsl;
        const int gw = bid * NWAVES + wave, ngw = G * NWAVES, gt = bid * NTHR + tid, ngt = G * NTHR;
        bf16_t* H = (bf16_t*)Q.out;
        bf16_t* BIG = (bf16_t*)(Q.ws + WS_BIG);
        bf16_t* X = (bf16_t*)(Q.ws + WS_H);
        int kind = 0, l = 0, c = 0, f = 0;
        if (pi == N_PHASES - 1) { kind = 11; l = DEPTH - 1; }
        else if (pi > 0) {
            const int q = pi - 1, pair = q / 25, rq = q % 25;
            int loc;
            if (rq < 18) { l = 2 * pair; loc = rq; } else { l = 2 * pair + 1; loc = rq - 18; }
            const int tail = (l & 1) ? 5 : 16;
            if (loc == 0) { kind = 1; f = 0; } else if (loc == 1) { kind = 2; f = 0; }
            else if (loc == tail) { kind = 1; f = 1; } else if (loc == tail + 1) { kind = 2; f = 1; }
            else if (l & 1) kind = 8 + (loc - 2);
            else if (loc < 14) { c = (loc - 2) >> 1; kind = 4 + ((loc - 2) & 1); }
            else kind = loc == 14 ? 6 : 7;
        }
        LAS float* tab = (LAS float*)scr_tab;
        float* PA = (float*)(Q.ws + WS_PA); float* PB = (float*)(Q.ws + WS_PB); float* PC = (float*)(Q.ws + WS_PC); const float* R2 = (const float*)(Q.ws + WS_R2);
        const WPtrs w = wptrs(Q.ws, l);
        const int j = l >> 1;
        if (rep && kind != PROBE_KIND) continue;
        if (st > 2 * lo) { if (st == 2 * lo + 2) grid.sync(); else xcd_barrier(xbar, tid); }
        const float rs = rep ? 0.0f : 1.0f;
        switch (kind) {
        case 0: prologue_phase(Q, gw, ngw, LANE()); break;
        case 1: { if (f) rowscale_prepass(tab, PB, nullptr, T, 2 * FF, 0, tid, bid, G, WGM_FIN);
                  else if (l == 0) rowscale_prepass(tab, nullptr, R2, T, 2 * FF, 0, tid, bid, G, WGM_FIN);
                  else rowscale_prepass(tab, PC, nullptr, T, 2 * FF, 0, tid, bid, G, WGM_FIN, PB);
                  EpiSwiglu E{BIG, tab}; run_gemm(lds, X, f ? w.f2in : w.f1in, T, 2 * FF, D, E, bid, G, tid, WGM_FIN); } break;
        case 2: case 7: case 10: {
            const bf16_t* A = kind == 7 ? H : BIG; const bf16_t* Bt = kind == 2 ? (f ? w.f2out : w.f1out) : (kind == 7 ? w.wo : w.sout);
            const bool lazy = kind == 2 && f == 0 && l > 0, c2 = kind == 2 && f == 1 && l < DEPTH - 1;
            if (lazy) rowscale_prepass(tab, PC, nullptr, T, D, 0, tid, bid, G, WGM_RES, nullptr, 1);
            EpiResid E{X, (kind == 2 ? 0.5f : 1.0f) * rs, kind == 2 ? (f ? (c2 ? PC : nullptr) : PA) : PB, tab, lazy ? Q.in[20] + (l - 1) * D : nullptr, c2 ? PB : nullptr, c2 ? Q.in[20] + l * D : nullptr}; run_gemm(lds, A, Bt, T, D, kind == 2 ? FF : D, E, bid, G, tid, WGM_RES, kind == 2 ? 1 : 0); } break;
        case 4: { rowscale_prepass(tab, PA, nullptr, CH, QKVW, c * CH, tid, bid, G, WGM_QKV);
                  EpiQKV E{BIG, c * CH, Q.in[7] + j * 64, Q.in[8] + j * 64, (const float*)(Q.ws + WS_ROPE), tab};
                  run_gemm(lds, X + (size_t)c * CH * D, w.qkv, CH, QKVW, D, E, bid, G, tid, WGM_QKV);
                  const int nlight = G - (CH / 256) * (QKVW / 256) % G;
                  if (c > 0 && bid >= G - nlight) combine_phase(Q, c - 1, (bid - (G - nlight)) * NTHR + tid, nlight * NTHR); } break;
#ifdef ATTN_OLD
        case 5: attn_phase(Q, lds, c, gw, ngw, wave, LANE(), rep * PROBE_VAR); break;
#else
        case 5: attn_phase_coop(Q, lds, c, bid, G, tid, wave, LANE(), rep * PROBE_VAR); break;
#endif
        case 6: combine_phase(Q, NCH - 1, gt, ngt); break;
        case 8: { rowscale_prepass(tab, PA, nullptr, T, 2 * D, 0, tid, bid, G, WGM_SIN);
                  EpiSguIn E{BIG, (bf16_t*)(Q.ws + WS_BIG + BIG_V), Q.in[11] + j * 2 * D, (float*)(Q.ws + WS_BIG + BIG_ST), tab}; run_gemm(lds, X, w.sin, T, 2 * D, D, E, bid, G, tid, WGM_SIN); } break;
        case 9: spatial_phase(Q, lds, l, tid, wave, LANE(), bid, G); break;
        default: norm_phase<2>(Q, Q.in[20] + l * D, true, gw, ngw, LANE()); break;
        }
#ifdef PROBE_SYNC
        xcd_barrier(xbar, tid);
#endif
    }
}

extern "C" void kernel_launch(void* const* d_in, const int* in_sizes, int n_in, void* d_out, int out_size, void* d_ws, size_t ws_size, hipStream_t stream) {
    static int grid = 0;
    if (grid == 0) {
        if (n_in != 21 || out_size != T * D || ws_size < WS_END) { fprintf(stderr, "kernel_launch: unexpected shapes (n_in %d out %d ws %zu need %zu)\n", n_in, out_size, ws_size, (size_t)WS_END); grid = -1; return; }
        int dev = 0, cus = 0, per_cu = 0;
        hipGetDevice(&dev); hipDeviceGetAttribute(&cus, hipDeviceAttributeMultiprocessorCount, dev);
        hipOccupancyMaxActiveBlocksPerMultiprocessor(&per_cu, (const void*)mega_fwd, NTHR, 0);
        if (per_cu < 1) { fprintf(stderr, "kernel_launch: occupancy query says %d blocks per CU\n", per_cu); per_cu = 1; }
        (void)hipGetLastError();
        grid = cus;
    }
    if (grid < 0) return;
    Params p{};
    for (int i = 0; i < 21; ++i) p.in[i] = (const float*)d_in[i];
    p.out = (float*)d_out; p.ws = (unsigned char*)d_ws;
#if PER_PHASE_LAUNCH
    for (int ph = 0; ph < N_PHASES; ++ph) { p.ph_lo = ph; p.ph_hi = ph + 1; hipLaunchKernelGGL(mega_fwd, dim3(grid), dim3(NTHR), 0, stream, p); }
#else
    p.ph_lo = 0; p.ph_hi = N_PHASES;
    if (hipMemsetAsync(d_ws, 0, 16384, stream) != hipSuccess) { fprintf(stderr, "kernel_launch: memset of the barrier words failed\n"); return; }
    void* args[] = {&p};
    hipError_t e = hipLaunchCooperativeKernel((const void*)mega_fwd, dim3(grid), dim3(NTHR), args, 0, stream);
    if (e != hipSuccess) fprintf(stderr, "kernel_launch: cooperative launch failed: %s (grid %d)\n", hipGetErrorString(e), grid);
#endif
}
```
